# Optimizing an MI355X kernel written in HIP

```python
import jax, jax.numpy as jnp
from jax import lax
import numpy as np

D_MODEL = 1024
BATCH = 2
SEQ = 8192
DEPTH = 1
DEC_BATCH = 128
DEC_SEQ = 4
PAST_LEN = 2048
PAGE_SIZE = 128

MIX_WIDTH = D_MODEL
MIX_A = MIX_WIDTH // 2
A_GROUPS = 8
A_DG = MIX_A // A_GROUPS
CHUNK = 128
MIX_B = MIX_WIDTH - MIX_A
HEAD_DIM = 64
N_HEADS = MIX_B // HEAD_DIM
N_KV = 4
Q_PER_KV = N_HEADS // N_KV
KV_W = N_KV * HEAD_DIM
L_CMP = 32
STRIDE = 16
CMP_HID = 256
L_SLC = 64
N_SEL = 16
WINDOW = 512
Q_BLOCK = 128
D_FF = -(-(8 * D_MODEL) // (3 * 256)) * 256
IN_COLS = 2 * MIX_A + MIX_B + 6 * KV_W + 3 * N_HEADS
ROPE_THETA = 10000.0
EPS = 1e-6
FORCED_SCORE = 1e4

kernel_name = 'hymba_gmlp_nsa_decoder_step'


def rmsnorm(x, g):
    xf = x.astype(jnp.float32)
    y = xf * lax.rsqrt(jnp.mean(xf * xf, axis=-1, keepdims=True) + EPS)
    return (y * g.astype(jnp.float32)).astype(x.dtype)


def modulate(x, g, shift, scale):
    return rmsnorm(x, g) * (1 + scale[:, None]) + shift[:, None]


def rope(x, pos):
    half = HEAD_DIM // 2
    inv = ROPE_THETA ** (-jnp.arange(half, dtype=jnp.float32) / half)
    ang = pos.astype(jnp.float32)[:, None] * inv[None, :]
    cos, sin = jnp.cos(ang)[:, None, :], jnp.sin(ang)[:, None, :]
    xf = x.astype(jnp.float32)
    x1, x2 = xf[..., :half], xf[..., half:]
    return jnp.concatenate([x1 * cos - x2 * sin, x2 * cos + x1 * sin], axis=-1).astype(x.dtype)


def masked_probs(s, mask):
    s = jnp.where(mask, s, -jnp.inf)
    m = jnp.max(s, axis=-1, keepdims=True)
    m = jnp.where(jnp.isfinite(m), m, 0.0)
    p = jnp.where(mask, jnp.exp(s - m), 0.0)
    return p / jnp.maximum(jnp.sum(p, axis=-1, keepdims=True), 1e-20)


def project(h, pos, w_in, g_sgu, g_q, g_k_cmp, g_k_slc, g_k_win):
    B, S = h.shape[:2]
    sizes = [MIX_A, MIX_A, MIX_B] + [KV_W] * 6
    cuts = [sum(sizes[:i + 1]) for i in range(len(sizes))]
    u, v, q, kc, vc, ks, vs, kw, vw, gl = jnp.split(h @ w_in, cuts, axis=-1)
    u = jax.nn.gelu(u).reshape(B, S, A_GROUPS, A_DG)
    v = rmsnorm(jax.nn.gelu(v).reshape(B, S, A_GROUPS, A_DG), g_sgu.reshape(A_GROUPS, A_DG))
    hd = lambda a, n: a.reshape(B, S, n, HEAD_DIM)
    q = rope(rmsnorm(hd(q, N_HEADS), g_q), pos)
    kc = rope(rmsnorm(hd(kc, N_KV), g_k_cmp), pos)
    ks = rope(rmsnorm(hd(ks, N_KV), g_k_slc), pos)
    kw = rope(rmsnorm(hd(kw, N_KV), g_k_win), pos)
    gates = jax.nn.sigmoid(gl.reshape(B, S, N_HEADS, 3))
    return u, v, q, kc, hd(vc, N_KV), ks, hd(vs, N_KV), kw, hd(vw, N_KV), gates


def chunk_mlp(u, v, w_s, b_s):
    B, S = u.shape[:2]
    n_c = -(-S // CHUNK)
    vp = jnp.pad(v, ((0, 0), (0, n_c * CHUNK - S), (0, 0), (0, 0)))
    vp = vp.reshape(B, n_c, CHUNK, A_GROUPS, A_DG)
    w = jnp.where(jnp.tril(jnp.ones((CHUNK, CHUNK), bool)), w_s, 0)
    mixed = jnp.einsum('gts,bcsgd->bctgd', w, vp) + b_s.T[None, None, :, :, None]
    mixed = mixed.reshape(B, n_c * CHUNK, A_GROUPS, A_DG)[:, :S]
    return (u * mixed).reshape(B, S, MIX_A)


def compress(k, pe, w1, w2):
    B, T = k.shape[:2]
    nc = (T - L_CMP) // STRIDE + 1
    idx = jnp.arange(nc)[:, None] * STRIDE + jnp.arange(L_CMP)[None, :]
    blk = k[:, idx] + pe[None, None, :, None, :]
    blk = blk.transpose(0, 1, 3, 2, 4).reshape(B, nc, N_KV, L_CMP * HEAD_DIM)
    return jax.nn.gelu(blk @ w1) @ w2


def to_blocks(k):
    B, T = k.shape[:2]
    n_s = -(-T // L_SLC)
    k = jnp.pad(k, ((0, 0), (0, n_s * L_SLC - T), (0, 0), (0, 0)))
    return k.reshape(B, n_s, L_SLC, N_KV, HEAD_DIM).transpose(0, 3, 1, 2, 4)


def nsa_context(kc, vc, ks, vs, pe_k, pe_v, w_ck1, w_ck2, w_cv1, w_cv2):
    kc_c = compress(kc, pe_k, w_ck1, w_ck2)
    vc_c = compress(vc, pe_v, w_cv1, w_cv2)
    c_end = jnp.arange(kc_c.shape[1]) * STRIDE + (L_CMP - 1)
    return kc_c, vc_c, c_end, to_blocks(ks), to_blocks(vs)


def nsa_core(q, gates, t, kc_c, vc_c, c_end, ks_blk, vs_blk, kw, vw, w_pos):
    B, Q = q.shape[:2]
    f32 = jnp.float32
    qg = q.astype(f32).reshape(B, Q, N_KV, Q_PER_KV, HEAD_DIM) * (HEAD_DIM ** -0.5)
    s_c = jnp.einsum('bqgrd,bcgd->bqgrc', qg, kc_c.astype(f32))
    p_c = masked_probs(s_c, (c_end[None, :] <= t[:, None])[None, :, None, None, :])
    o_c = jnp.einsum('bqgrc,bcgd->bqgrd', p_c, vc_c.astype(f32))
    n_c, n_s = c_end.shape[0], ks_blk.shape[2]
    c_start = jnp.arange(n_c) * STRIDE
    blk = jnp.arange(n_s)
    overlap = ((c_start[:, None] < (blk[None, :] + 1) * L_SLC)
               & (c_start[:, None] + L_CMP > blk[None, :] * L_SLC)).astype(f32)
    imp = jnp.einsum('bqgrc,cn->bqgn', p_c, overlap)
    cur = t // L_SLC
    valid = blk[None, :] <= cur[:, None]
    forced = valid & ((blk[None, :] == 0) | (blk[None, :] >= cur[:, None] - 1))
    score = jnp.where(forced[None, :, None, :], FORCED_SCORE,
                      jnp.where(valid[None, :, None, :], imp, -jnp.inf))
    _, idx = lax.top_k(score, min(N_SEL, n_s))
    bi = jnp.arange(B)[:, None, None, None]
    gi = jnp.arange(N_KV)[None, None, :, None]
    n_k = idx.shape[-1] * L_SLC
    kb = ks_blk[bi, gi, idx].reshape(B, Q, N_KV, n_k, HEAD_DIM).astype(f32)
    vb = vs_blk[bi, gi, idx].reshape(B, Q, N_KV, n_k, HEAD_DIM).astype(f32)
    tok = (idx[..., None] * L_SLC + jnp.arange(L_SLC)).reshape(B, Q, N_KV, n_k)
    s_s = jnp.einsum('bqgrd,bqgkd->bqgrk', qg, kb)
    p_s = masked_probs(s_s, (tok <= t[None, :, None, None])[:, :, :, None, :])
    o_s = jnp.einsum('bqgrk,bqgkd->bqgrd', p_s, vb)
    s_w = jnp.einsum('bqgrd,bkgd->bqgrk', qg, kw.astype(f32))
    rel = t[:, None] - w_pos[None, :]
    m_w = (rel >= 0) & (rel < WINDOW) & (w_pos[None, :] >= 0)
    p_w = masked_probs(s_w, m_w[None, :, None, None, :])
    o_w = jnp.einsum('bqgrk,bkgd->bqgrd', p_w, vw.astype(f32))
    g = gates.astype(f32).reshape(B, Q, N_KV, Q_PER_KV, 3)
    o = g[..., 0:1] * o_c + g[..., 1:2] * o_s + g[..., 2:3] * o_w
    return o.reshape(B, Q, MIX_B).astype(q.dtype)


def nsa_prompt(q, gates, kc_c, vc_c, c_end, ks_blk, vs_blk, kw, vw):
    B, S = q.shape[:2]
    pad = ((0, 0), (WINDOW, 0), (0, 0), (0, 0))
    kw_pad, vw_pad = jnp.pad(kw, pad), jnp.pad(vw, pad)

    def block(qs):
        t = qs + jnp.arange(Q_BLOCK)
        qb = lax.dynamic_slice_in_dim(q, qs, Q_BLOCK, axis=1)
        gb = lax.dynamic_slice_in_dim(gates, qs, Q_BLOCK, axis=1)
        kwb = lax.dynamic_slice_in_dim(kw_pad, qs, WINDOW + Q_BLOCK, axis=1)
        vwb = lax.dynamic_slice_in_dim(vw_pad, qs, WINDOW + Q_BLOCK, axis=1)
        w_pos = qs - WINDOW + jnp.arange(WINDOW + Q_BLOCK)
        return nsa_core(qb, gb, t, kc_c, vc_c, c_end, ks_blk, vs_blk, kwb, vwb, w_pos)

    out = lax.map(block, jnp.arange(S // Q_BLOCK) * Q_BLOCK)
    return out.transpose(1, 0, 2, 3).reshape(B, S, MIX_B)


def gather_pages(cache, page_table):
    rows = cache[page_table]
    return rows.reshape(page_table.shape[0], -1, N_KV, HEAD_DIM)


def finish(x, mix, gate1, shift2, scale2, gate2, w_out, g_ffn_norm, w_ffn_in, w_ffn_out):
    x = x + gate1[:, None] * (mix @ w_out)
    h = modulate(x, g_ffn_norm, shift2, scale2)
    a, b = jnp.split(h @ w_ffn_in, 2, axis=-1)
    return x + gate2[:, None] * ((jax.nn.silu(a) * b) @ w_ffn_out)


def setup_inputs(seed: int = 0) -> dict:
    key = jax.random.key(seed)
    k = jax.random.split(key, 32)
    n_pages = PAST_LEN // PAGE_SIZE
    n_pool = (DEC_BATCH * n_pages * 5) // 4
    wb = min(WINDOW, PAST_LEN)
    f32 = jnp.float32

    def nrm(i, shape, scale=1.0):
        return jax.random.normal(k[i], shape, f32) * scale

    def gain(i, shape):
        return 1.0 + nrm(i, shape, 0.05)

    page_table = jax.random.permutation(k[0], n_pool)[:DEC_BATCH * n_pages]
    page_table = page_table.reshape(DEC_BATCH, n_pages).astype(jnp.int32)
    cache_shape = (DEPTH, n_pool, PAGE_SIZE, N_KV, HEAD_DIM)
    win_shape = (DEPTH, DEC_BATCH, wb, N_KV, HEAD_DIM)
    return {
        'x_prompt': nrm(1, (BATCH, SEQ, D_MODEL)),
        'x_sample': nrm(2, (DEC_BATCH, DEC_SEQ, D_MODEL)),
        'cache_k_cmp': nrm(3, cache_shape),
        'cache_v_cmp': nrm(4, cache_shape),
        'cache_k_slc': nrm(5, cache_shape),
        'cache_v_slc': nrm(6, cache_shape),
        'state_k_win': nrm(7, win_shape),
        'state_v_win': nrm(8, win_shape),
        'page_table': page_table,
        'c_prompt': nrm(9, (BATCH, D_MODEL)),
        'c_sample': nrm(10, (DEC_BATCH, D_MODEL)),
        'w_ada': nrm(11, (DEPTH, D_MODEL, 6 * D_MODEL), 0.5 * D_MODEL ** -0.5),
        'b_ada': nrm(12, (DEPTH, 6 * D_MODEL), 0.1),
        'g_mix_norm': gain(13, (DEPTH, D_MODEL)),
        'g_ffn_norm': gain(14, (DEPTH, D_MODEL)),
        'w_in': nrm(15, (DEPTH, D_MODEL, IN_COLS), D_MODEL ** -0.5),
        'g_sgu': gain(16, (DEPTH, MIX_A)),
        'w_sgu': nrm(17, (DEPTH, A_GROUPS, CHUNK, CHUNK), CHUNK ** -0.5),
        'b_sgu': 1.0 + nrm(18, (DEPTH, A_GROUPS, CHUNK), 0.1),
        'g_q': gain(19, (DEPTH, HEAD_DIM)),
        'g_k_cmp': gain(20, (DEPTH, HEAD_DIM)),
        'g_k_slc': gain(21, (DEPTH, HEAD_DIM)),
        'g_k_win': gain(22, (DEPTH, HEAD_DIM)),
        'pe_k_cmp': nrm(23, (DEPTH, L_CMP, HEAD_DIM), 0.1),
        'pe_v_cmp': nrm(24, (DEPTH, L_CMP, HEAD_DIM), 0.1),
        'w_ck1': nrm(25, (DEPTH, L_CMP * HEAD_DIM, CMP_HID), (L_CMP * HEAD_DIM) ** -0.5),
        'w_ck2': nrm(26, (DEPTH, CMP_HID, HEAD_DIM), CMP_HID ** -0.5),
        'w_cv1': nrm(27, (DEPTH, L_CMP * HEAD_DIM, CMP_HID), (L_CMP * HEAD_DIM) ** -0.5),
        'w_cv2': nrm(28, (DEPTH, CMP_HID, HEAD_DIM), CMP_HID ** -0.5),
        'w_out': nrm(29, (DEPTH, MIX_WIDTH, D_MODEL), MIX_WIDTH ** -0.5),
        'w_ffn_in': nrm(30, (DEPTH, D_MODEL, 2 * D_FF), D_MODEL ** -0.5),
        'w_ffn_out': nrm(31, (DEPTH, D_FF, D_MODEL), D_FF ** -0.5),
    }


def reference(x_prompt, x_sample, cache_k_cmp, cache_v_cmp, cache_k_slc, cache_v_slc,
              state_k_win, state_v_win, page_table, c_prompt, c_sample,
              w_ada, b_ada, g_mix_norm, g_ffn_norm, w_in, g_sgu, w_sgu, b_sgu,
              g_q, g_k_cmp, g_k_slc, g_k_win, pe_k_cmp, pe_v_cmp,
              w_ck1, w_ck2, w_cv1, w_cv2, w_out, w_ffn_in, w_ffn_out):
    B, S = x_prompt.shape[:2]
    n_new = x_sample.shape[1]
    pos_p = jnp.arange(S)
    pos_s = PAST_LEN + jnp.arange(n_new)
    wb_p = min(WINDOW, S)
    wb_s = state_k_win.shape[2]
    open_p = S - ((S - 1) // CHUNK) * CHUNK
    xp, xs = x_prompt, x_sample
    sp = [[] for _ in range(7)]
    ss = [[] for _ in range(7)]
    for l in range(DEPTH):
        proj_w = (w_in[l], g_sgu[l], g_q[l], g_k_cmp[l], g_k_slc[l], g_k_win[l])
        cmp_w = (pe_k_cmp[l], pe_v_cmp[l], w_ck1[l], w_ck2[l], w_cv1[l], w_cv2[l])
        ffn_w = (w_out[l], g_ffn_norm[l], w_ffn_in[l], w_ffn_out[l])

        sh1, sc1, gt1, sh2, sc2, gt2 = jnp.split(jax.nn.silu(c_prompt) @ w_ada[l] + b_ada[l], 6, axis=-1)
        h = modulate(xp, g_mix_norm[l], sh1, sc1)
        u, v, q, kc, vc, ks, vs, kw, vw, gates = project(h, pos_p, *proj_w)
        a_out = chunk_mlp(u, v, w_sgu[l], b_sgu[l])
        ctx = nsa_context(kc, vc, ks, vs, *cmp_w)
        b_out = nsa_prompt(q, gates, *ctx, kw, vw)
        xp = finish(xp, jnp.concatenate([a_out, b_out], axis=-1), gt1, sh2, sc2, gt2, *ffn_w)
        for lst, val in zip(sp, (kc, vc, ks, vs, kw[:, S - wb_p:], vw[:, S - wb_p:],
                                 v.reshape(B, S, MIX_A)[:, S - open_p:])):
            lst.append(val)

        sh1, sc1, gt1, sh2, sc2, gt2 = jnp.split(jax.nn.silu(c_sample) @ w_ada[l] + b_ada[l], 6, axis=-1)
        h = modulate(xs, g_mix_norm[l], sh1, sc1)
        u, v, q, kc, vc, ks, vs, kw, vw, gates = project(h, pos_s, *proj_w)
        a_out = chunk_mlp(u, v, w_sgu[l], b_sgu[l])
        past = lambda cache: gather_pages(cache[l], page_table)
        ctx = nsa_context(jnp.concatenate([past(cache_k_cmp), kc], axis=1),
                          jnp.concatenate([past(cache_v_cmp), vc], axis=1),
                          jnp.concatenate([past(cache_k_slc), ks], axis=1),
                          jnp.concatenate([past(cache_v_slc), vs], axis=1), *cmp_w)
        kw_all = jnp.concatenate([state_k_win[l], kw], axis=1)
        vw_all = jnp.concatenate([state_v_win[l], vw], axis=1)
        w_pos = PAST_LEN - wb_s + jnp.arange(wb_s + n_new)
        b_out = nsa_core(q, gates, pos_s, *ctx, kw_all, vw_all, w_pos)
        xs = finish(xs, jnp.concatenate([a_out, b_out], axis=-1), gt1, sh2, sc2, gt2, *ffn_w)
        for lst, val in zip(ss, (kc, vc, ks, vs, kw_all[:, n_new:], vw_all[:, n_new:],
                                 v.reshape(xs.shape[0], n_new, MIX_A))):
            lst.append(val)

    p_k_cmp, p_v_cmp, p_k_slc, p_v_slc, p_k_win, p_v_win, p_chunk_v = [jnp.stack(a) for a in sp]
    s_k_cmp, s_v_cmp, s_k_slc, s_v_slc, s_k_win, s_v_win, s_chunk_v = [jnp.stack(a) for a in ss]
    return (xp, xs, p_k_cmp, p_v_cmp, p_k_slc, p_v_slc, p_k_win, p_v_win, p_chunk_v,
            s_k_cmp, s_v_cmp, s_k_slc, s_v_slc, s_k_win, s_v_win, s_chunk_v)
```

```cpp
#include <hip/hip_runtime.h>
#include <cstdio>
#include <cstdint>

#define LAS __attribute__((address_space(3)))
#define GAS __attribute__((address_space(1)))
typedef unsigned short bf16_t;
typedef short bf16x8 __attribute__((ext_vector_type(8)));
typedef short s16x4 __attribute__((ext_vector_type(4)));
typedef float f32x2 __attribute__((ext_vector_type(2)));
typedef float f32x4 __attribute__((ext_vector_type(4)));
typedef float f32x16 __attribute__((ext_vector_type(16)));
typedef unsigned u32x2 __attribute__((ext_vector_type(2)));
typedef unsigned u32x4 __attribute__((ext_vector_type(4)));

constexpr int DM = 1024, SEQ = 8192, NB = 2, NPR = NB * SEQ;
constexpr int NSEQ = 128, NNEW = 4, NSR = NSEQ * NNEW, PAST = 2048;
constexpr int NR = NPR + NSR;
constexpr int INC = 3096, INCP = 3328, DFF = 2816;
constexpr int TC = 2048;
constexpr int TS = 2112;
constexpr int TW = 576;
constexpr float EPS = 1e-6f;
constexpr float C2 = 0.125f * 1.4426950408889634f;

constexpr size_t O_YP = 0, O_YS = 16777216, O_PKC = 17301504, O_PVC = 21495808, O_PKS = 25690112, O_PVS = 29884416,
                 O_PKW = 34078720, O_PVW = 34340864, O_PCV = 34603008, O_SKC = 34734080, O_SVC = 34865152, O_SKS = 34996224,
                 O_SVS = 35127296, O_SKW = 35258368, O_SVW = 52035584, O_SCV = 68812800, O_TOTAL = 69074944;

constexpr size_t MiB = 1u << 20;
constexpr size_t WS_CTL = 0, CTL_ZERO_BYTES = 128 * 1024;
constexpr size_t WS_WTIN = 1 * MiB, WS_WTOUT = 8 * MiB, WS_WTF1 = 10 * MiB, WS_WTF2 = 21 * MiB, WS_WTC1K = 27 * MiB, WS_WTC1V = 28 * MiB;
constexpr size_t WS_W2TK = 29 * MiB, WS_W2TV = 29 * MiB + 32768, WS_SGUW = 29 * MiB + 65536, WS_PEB = 29 * MiB + 524288;
constexpr size_t WS_ROPE = 30 * MiB, WS_MOD = 33 * MiB, WS_GATES = 37 * MiB;
constexpr size_t WS_H = 40 * MiB, WS_U = 74 * MiB, WS_V = 91 * MiB, WS_Q = 108 * MiB, WS_MIX = 125 * MiB;
constexpr size_t WS_KS = 160 * MiB, WS_VS = 168 * MiB, WS_KW = 176 * MiB, WS_VW = 184 * MiB;
constexpr size_t WS_AK = 192 * MiB, WS_AV = 330 * MiB;
constexpr size_t WS_CKS = 468 * MiB, WS_CVS = 601 * MiB, WS_CWK = 734 * MiB, WS_CWV = 771 * MiB;
constexpr size_t WS_HIDK = 808 * MiB, WS_HIDV = 843 * MiB, WS_KCC = 878 * MiB, WS_VCC = 887 * MiB;
constexpr size_t WS_X1 = 896 * MiB, WS_F = 963 * MiB, WS_END = 1056 * MiB;
constexpr int CW_BAR = 4096;
constexpr int NCROWS = 4096 + NSEQ * 4 * 128;

constexpr int RING_BYTES = 131072, LDSCTL_OFF = RING_BYTES, MISC_OFF = LDSCTL_OFF + 320, LDS_BYTES = 163840;
constexpr int NWAVES = 8;

struct Params {
    const float* in[32];
    float* out;
    unsigned char* ws;
    int ph_lo, ph_hi, li, pad;
};

__device__ __forceinline__ unsigned cvt_pk_bf16(float lo, float hi) { unsigned r; asm volatile("v_cvt_pk_bf16_f32 %0, %1, %2" : "=v"(r) : "v"(lo), "v"(hi)); return r; }
__device__ __forceinline__ float bf2f(unsigned short b) { return __builtin_bit_cast(float, (unsigned)b << 16); }
__device__ __forceinline__ float bflo(unsigned w) { return __builtin_bit_cast(float, w << 16); }
__device__ __forceinline__ float bfhi(unsigned w) { return __builtin_bit_cast(float, w & 0xffff0000u); }
__device__ __forceinline__ float fast_exp2(float x) { return __builtin_amdgcn_exp2f(x); }
__device__ __forceinline__ float fast_rcp(float x) { return __builtin_amdgcn_rcpf(x); }
__device__ __forceinline__ float sigmoidf_(float x) { return fast_rcp(1.f + fast_exp2(-1.4426950408889634f * x)); }
__device__ __forceinline__ float siluf_(float x) { return x * sigmoidf_(x); }
__device__ __forceinline__ float geluf_(float x) { const float z = 0.7978845608028654f * (x + 0.044715f * x * x * x); return x * sigmoidf_(2.f * z); }
__device__ __forceinline__ float wave_sum(float v) {
#pragma unroll
    for (int o = 1; o < 64; o <<= 1) v += __shfl_xor(v, o);
    return v;
}
__device__ __forceinline__ int crow(int r, int hi) { return (r & 3) + 8 * (r >> 2) + 4 * hi; }
template <class T> __device__ __forceinline__ T* launder_gptr(T* p) { GAS T* g = (GAS T*)p; asm volatile("" : "+s"(g)); return (T*)g; }
#define LAUNDER_GPTR(p) do { p = launder_gptr(p); } while (0)
__device__ __forceinline__ int fresh_lane() { int l; asm volatile("v_mbcnt_lo_u32_b32 %0, -1, 0\n\tv_mbcnt_hi_u32_b32 %0, -1, %0" : "=v"(l)); return l; }
#define LDS_WAIT() asm volatile("s_waitcnt lgkmcnt(0)" ::: "memory")
#define VM_WAIT() asm volatile("s_waitcnt vmcnt(0)" ::: "memory")
namespace pg8 {
#define PG8_LAS __attribute__((address_space(3)))
constexpr int BM = 256, BK = 64, HALF = 128, HTB = HALF * BK * 2  , STAGE_BYTES = 8 * HTB, NXCD = 8, WGM = 8;

__host__ __device__ __forceinline__ int lds_byte(int r, int c) { const int st = (r >> 4) * 2 + (c >> 5), rr = r & 15, cc = c & 31, ob = rr * 64 + cc * 2; return st * 1024 + (ob ^ (((ob >> 9) & 1) << 5)); }
__host__ __device__ __forceinline__ void stage_rc(int b, int& R, int& C) { const int st = b / 1024, sb = b % 1024, swz = sb ^ (((sb >> 9) & 1) << 5); R = (st >> 1) * 16 + swz / 64; C = (st & 1) * 32 + (swz % 64) / 2; }
__host__ __device__ __forceinline__ int perm32(int rho) { const int n = rho >> 4, i = rho & 15; return 8 * (i >> 2) + 4 * n + (i & 3); }

struct Unit { int pm, pn, kind; };
struct Gemm { const bf16_t* A; const bf16_t* Bt; int M, N, K, lda, ldb; };
struct StaticOrder {
    int nM, nN, nwg, G, c;
    __host__ __device__ void init(int M, int N, int G_, int c_) { nM = M / BM; nN = N / BM; nwg = nM * nN; G = G_; c = c_; }
    __device__ __forceinline__ const char* abase(const Gemm& g, const Unit& u) const { return (const char*)g.A + (size_t)u.pm * ((size_t)BM * g.lda * 2); }
    __device__ __forceinline__ const char* bbase(const Gemm& g, const Unit& u) const { return (const char*)g.Bt + (size_t)u.pn * ((size_t)BM * g.ldb * 2); }
    __host__ __device__ bool next(int i, Unit& u) const {
        u.kind = 0; const long L = (long)i * G + c; if (L >= nwg) return false;
        int wgid = (int)L; { const int q = nwg / NXCD, r = nwg % NXCD, xcd = wgid % NXCD, off = wgid / NXCD; wgid = (xcd < r ? xcd * (q + 1) : r * (q + 1) + (xcd - r) * q) + off; }
        const int nig = WGM * nN, gid = wgid / nig, fm = gid * WGM, gsz = (nM - fm) < WGM ? (nM - fm) : WGM;
        u.pm = fm + ((wgid % nig) % gsz); u.pn = (wgid % nig) / gsz; return true;
    }
    __device__ __forceinline__ void a_ready(const Unit&) const {}
    __device__ __forceinline__ void done(const Unit&) const {}
};
template <class Epi, class Sched, bool ALIGN_EPI = false, bool SP2 = false>
__device__ __forceinline__ void gemm_phase(PG8_LAS unsigned char* lds, const Gemm g, const Sched& S, const Epi& E, int wave_sgpr) {
    int tid_ = wave_sgpr * 64 + fresh_lane();
    const int tid = tid_, wid = __builtin_amdgcn_readfirstlane(tid >> 6), lane = tid & 63, wr = wid >> 2, wc = wid & 3, fr = lane & 15, fq = lane >> 4;
    const int K = g.K, nt = K / BK;
    unsigned voffA[2], voffB[2];
#pragma unroll
    for (int i = 0; i < 2; ++i) { int R, C; stage_rc(tid * 16 + i * 8192, R, C); const int Rb = Epi::PERM ? ((R & ~31) + perm32(R & 31)) : R;
        voffA[i] = (unsigned)(R * g.lda + C) * 2u; voffB[i] = (unsigned)(Rb * g.ldb + C) * 2u; }
    const size_t kstep = (size_t)(BK * 2);
    const size_t hstepA = (size_t)HALF * g.lda * 2, hstepB = (size_t)HALF * g.ldb * 2;
    const unsigned ldsw = (unsigned)wid * 1024u;
    const int aoff = lds_byte(wr * 64 + fr, fq * 8), boff = lds_byte(wc * 32 + fr, fq * 8);
#define PG8_SA(b, h) (((b) * 2 + (h)) * HTB)
#define PG8_SB(b, h) ((4 + (b) * 2 + (h)) * HTB)
#define PG8_STAGE(bufoff, gbase, voff) do { _Pragma("unroll") for (int _i = 0; _i < 2; ++_i) \
        __builtin_amdgcn_global_load_lds((const unsigned*)((const char*)(gbase) + (voff)[_i]), (PG8_LAS unsigned*)(lds + (bufoff) + ldsw + _i * 8192), 16, 0, 0); } while (0)
#define PG8_LDA(dst, b, h) do { _Pragma("unroll") for (int m = 0; m < 4; ++m) _Pragma("unroll") for (int k = 0; k < 2; ++k) dst[m][k] = *(const PG8_LAS bf16x8*)(lds + PG8_SA(b, h) + aoff + m * 2048 + k * 1024); } while (0)
#define PG8_LDB(dst, b, h) do { _Pragma("unroll") for (int n = 0; n < 2; ++n) _Pragma("unroll") for (int k = 0; k < 2; ++k) dst[n][k] = *(const PG8_LAS bf16x8*)(lds + PG8_SB(b, h) + boff + n * 2048 + k * 1024); } while (0)
#define PG8_MMA(ai, bj, At, Bt) do { __builtin_amdgcn_s_setprio(1); _Pragma("unroll") for (int m = 0; m < 4; ++m) _Pragma("unroll") for (int n = 0; n < 2; ++n) _Pragma("unroll") for (int k = 0; k < 2; ++k) \
        acc[ai][bj][m][n] = __builtin_amdgcn_mfma_f32_16x16x32_bf16(Bt[n][k], At[m][k], acc[ai][bj][m][n], 0, 0, 0); __builtin_amdgcn_s_setprio(0); } while (0)
#define PG8_WAIT_V(n) asm volatile("s_waitcnt vmcnt(" #n ")" ::: "memory")
#define PG8_WAIT_L(n) asm volatile("s_waitcnt lgkmcnt(" #n ")" ::: "memory")
#define PG8_BAR __builtin_amdgcn_s_barrier()
#define PG8_SCHED __builtin_amdgcn_sched_barrier(0)
    Unit cur, nxt; int ui = 0;
    if (!S.next(0, cur)) return;
    f32x4 acc[2][2][4][2];
#pragma unroll
    for (int a = 0; a < 2; ++a)
#pragma unroll
        for (int b = 0; b < 2; ++b)
#pragma unroll
            for (int m = 0; m < 4; ++m)
#pragma unroll
                for (int n = 0; n < 2; ++n) acc[a][b][m][n] = (f32x4){0.f, 0.f, 0.f, 0.f};
    bf16x8 At[4][2], B0[2][2], B1[2][2];
    const char* cA = S.abase(g, cur); const char* cB = S.bbase(g, cur);
    S.a_ready(cur);
    if constexpr (SP2) {
        PG8_STAGE(PG8_SB(0, 0), cB, voffB); PG8_STAGE(PG8_SB(0, 1), cB + hstepB, voffB); PG8_STAGE(PG8_SA(0, 0), cA, voffA); PG8_STAGE(PG8_SA(0, 1), cA + hstepA, voffA);
        if (wr == 1) PG8_BAR;
        PG8_WAIT_V(2); PG8_BAR;
        PG8_STAGE(PG8_SB(1, 0), cB + kstep, voffB); PG8_STAGE(PG8_SA(1, 0), cA + kstep, voffA); PG8_STAGE(PG8_SB(1, 1), cB + hstepB + kstep, voffB);
        PG8_WAIT_V(6); PG8_BAR;
    } else {
        PG8_STAGE(PG8_SB(0, 0), cB, voffB); PG8_STAGE(PG8_SA(0, 0), cA, voffA); PG8_STAGE(PG8_SB(0, 1), cB + hstepB, voffB); PG8_STAGE(PG8_SA(0, 1), cA + hstepA, voffA);
        if (wr == 1) PG8_BAR;
        PG8_WAIT_V(4); PG8_BAR;
        PG8_STAGE(PG8_SB(1, 0), cB + kstep, voffB); PG8_STAGE(PG8_SA(1, 0), cA + kstep, voffA); PG8_STAGE(PG8_SB(1, 1), cB + hstepB + kstep, voffB);
        PG8_WAIT_V(6); PG8_BAR;
    }
    for (;;) {
        const bool has_next = S.next(ui + 1, nxt);
        const char* nA = has_next ? S.abase(g, nxt) : cA; const char* nB = has_next ? S.bbase(g, nxt) : cB;
        for (int t = 0; t < nt; t += 2) {
            const bool last = (t == nt - 2);
            const char* a1 = cA + (size_t)(t + 1) * kstep;
            const char* a2 = last ? nA : cA + (size_t)(t + 2) * kstep; const char* b2 = last ? nB : cB + (size_t)(t + 2) * kstep;
            const char* a3 = a2 + kstep; const char* b3 = b2 + kstep;
            if (last && has_next) S.a_ready(nxt);
            if constexpr (SP2) {
            PG8_LDB(B0, 0, 0); PG8_LDB(B1, 0, 1); PG8_SCHED; PG8_LDA(At, 0, 0); PG8_STAGE(PG8_SA(1, 1), a1 + hstepA, voffA);
            PG8_WAIT_V(8); PG8_WAIT_L(0); PG8_BAR; PG8_MMA(0, 0, At, B0); PG8_MMA(0, 1, At, B1); PG8_BAR; PG8_SCHED;
            PG8_LDA(At, 0, 1); PG8_STAGE(PG8_SB(0, 0), b2, voffB); PG8_STAGE(PG8_SB(0, 1), b2 + hstepB, voffB); PG8_STAGE(PG8_SA(0, 0), a2, voffA);
            PG8_WAIT_V(8); PG8_WAIT_L(0); PG8_BAR; PG8_MMA(1, 0, At, B0); PG8_MMA(1, 1, At, B1); PG8_BAR; PG8_SCHED;
            PG8_LDB(B0, 1, 0); PG8_LDB(B1, 1, 1); PG8_SCHED; PG8_LDA(At, 1, 0); PG8_STAGE(PG8_SA(0, 1), a2 + hstepA, voffA);
            PG8_WAIT_V(8); PG8_WAIT_L(0); PG8_BAR; PG8_MMA(0, 0, At, B0); PG8_MMA(0, 1, At, B1); PG8_BAR; PG8_SCHED;
            PG8_LDA(At, 1, 1); PG8_STAGE(PG8_SB(1, 0), b3, voffB); PG8_STAGE(PG8_SB(1, 1), b3 + hstepB, voffB); PG8_STAGE(PG8_SA(1, 0), a3, voffA);
            PG8_WAIT_V(8); PG8_WAIT_L(0); PG8_BAR; PG8_MMA(1, 0, At, B0); PG8_MMA(1, 1, At, B1); PG8_BAR; PG8_SCHED;
            } else {
            PG8_LDB(B0, 0, 0); PG8_SCHED; PG8_LDA(At, 0, 0); PG8_STAGE(PG8_SA(1, 1), a1 + hstepA, voffA);
            PG8_WAIT_L(8); PG8_BAR; PG8_WAIT_L(0); PG8_MMA(0, 0, At, B0); PG8_BAR; PG8_SCHED;
            PG8_LDB(B1, 0, 1); PG8_STAGE(PG8_SB(0, 0), b2, voffB);
            PG8_BAR; PG8_WAIT_L(0); PG8_MMA(0, 1, At, B1); PG8_BAR;
            PG8_LDA(At, 0, 1); PG8_STAGE(PG8_SA(0, 0), a2, voffA);
            PG8_BAR; PG8_WAIT_L(0); PG8_MMA(1, 0, At, B0); PG8_BAR; PG8_SCHED;
            PG8_STAGE(PG8_SB(0, 1), b2 + hstepB, voffB);
            PG8_WAIT_V(6); PG8_BAR; PG8_MMA(1, 1, At, B1); PG8_BAR;
            PG8_LDB(B0, 1, 0); PG8_SCHED; PG8_LDA(At, 1, 0); PG8_STAGE(PG8_SA(0, 1), a2 + hstepA, voffA);
            PG8_WAIT_L(8); PG8_BAR; PG8_WAIT_L(0); PG8_MMA(0, 0, At, B0); PG8_BAR; PG8_SCHED;
            PG8_LDB(B1, 1, 1); PG8_STAGE(PG8_SB(1, 0), b3, voffB);
            PG8_BAR; PG8_WAIT_L(0); PG8_MMA(0, 1, At, B1); PG8_BAR;
            PG8_LDA(At, 1, 1); PG8_STAGE(PG8_SA(1, 0), a3, voffA);
            PG8_BAR; PG8_WAIT_L(0); PG8_MMA(1, 0, At, B0); PG8_BAR; PG8_SCHED;
            PG8_STAGE(PG8_SB(1, 1), b3 + hstepB, voffB);
            PG8_WAIT_V(6); PG8_BAR; PG8_MMA(1, 1, At, B1); PG8_BAR;
            }
        }
        if constexpr (ALIGN_EPI) { if (wr == 0) PG8_BAR; }
        if constexpr (!Epi::AFTER_DRAIN) { E(acc, cur, wr, wc, fr, fq); S.done(cur); }
        if (!has_next) break;
#pragma unroll
        for (int a = 0; a < 2; ++a)
#pragma unroll
            for (int b = 0; b < 2; ++b)
#pragma unroll
                for (int m = 0; m < 4; ++m)
#pragma unroll
                    for (int n = 0; n < 2; ++n) acc[a][b][m][n] = (f32x4){0.f, 0.f, 0.f, 0.f};
        cur = nxt; cA = nA; cB = nB; ++ui;
        if constexpr (ALIGN_EPI) { if (wr == 1) PG8_BAR; }
    }
    PG8_WAIT_V(0);
    if constexpr (!ALIGN_EPI) { if (wr == 0) PG8_BAR; }
    PG8_BAR;
    if constexpr (Epi::AFTER_DRAIN) { E.fused(acc, cur, wr, wc, fr, fq, lds, wid, lane); S.done(cur); }
#undef PG8_SA
#undef PG8_SB
#undef PG8_STAGE
#undef PG8_LDA
#undef PG8_LDB
#undef PG8_MMA
#undef PG8_WAIT_V
#undef PG8_WAIT_L
#undef PG8_BAR
#undef PG8_SCHED
}
}

#define XB_TMO      128
#define XB_XCNT(j)  (256  + 64 * (j))
#define XB_XSUB(j)  (1280 + 64 * (j))
#define XB_XGEN(j)  (2304 + 64 * (j))
#define XB_TOP      3328
#define XB_TOPGEN   3392
#define XCD_BAR_WORDS 3456
#define XB_SPIN_CAP (1u << 18)

__device__ __forceinline__ unsigned xb_ld(unsigned* p)              { return __hip_atomic_load(p, __ATOMIC_RELAXED, __HIP_MEMORY_SCOPE_AGENT); }
__device__ __forceinline__ unsigned xb_add(unsigned* p, unsigned v) { return __hip_atomic_fetch_add(p, v, __ATOMIC_RELAXED, __HIP_MEMORY_SCOPE_AGENT); }
__device__ __forceinline__ unsigned xb_xcc_id() { return (unsigned)__builtin_amdgcn_s_getreg((3 << 11) | 20) & 0xFu; }
#define XB_SPIN(cond, bar) do { unsigned _sp = 0; while (cond) { __builtin_amdgcn_s_sleep(1); \
    if ((++_sp & 255u) == 0u) { if (xb_ld(&(bar)[XB_TMO])) break; if (_sp > XB_SPIN_CAP) { atomicAdd(&(bar)[XB_TMO], 1u); break; } } } } while (0)

struct XcdBarrier {
    unsigned* bar; unsigned x;
    volatile LAS unsigned* st;
};

__device__ __forceinline__ XcdBarrier xcd_barrier_post(unsigned* bar, volatile LAS unsigned* st) {
    XcdBarrier b; b.bar = bar; b.x = xb_xcc_id(); b.st = st;
    if (threadIdx.x == 0) (void)xb_add(&bar[XB_XCNT(b.x)], 1u);
    return b;
}
__device__ __forceinline__ void xcd_barrier_complete(unsigned* bar, unsigned x, unsigned& nloc, unsigned& nx) {
    const unsigned G = gridDim.x * gridDim.y * gridDim.z;
    unsigned sum, cnt, mine, sp = 0u;
    for (;;) {
        sum = 0u; cnt = 0u; mine = 0u;
#pragma unroll
        for (unsigned j = 0; j < 16; ++j) { const unsigned c = xb_ld(&bar[XB_XCNT(j)]); sum += c; cnt += (c > 0u) ? 1u : 0u; mine = (j == x) ? c : mine; }
        if (sum == G) break;
        __builtin_amdgcn_s_sleep(1);
        if ((++sp & 255u) == 0u) { if (xb_ld(&bar[XB_TMO])) break; if (sp > XB_SPIN_CAP) { atomicAdd(&bar[XB_TMO], 1u); break; } }
    }
    nloc = mine > 0u ? mine : 1u; nx = cnt > 0u ? cnt : 1u;
}

__device__ __forceinline__ void xcd_barrier(const XcdBarrier& b, int wave_sgpr) {
    asm volatile("s_waitcnt vmcnt(0)" ::: "memory");
    __syncthreads();
    if (wave_sgpr == 0 && fresh_lane() == 0) {
        unsigned* bar = b.bar;
        __builtin_amdgcn_s_waitcnt(0);
        unsigned nloc = b.st[0], nx = b.st[1];
        if (nloc == 0u) { xcd_barrier_complete(bar, b.x, nloc, nx); b.st[0] = nloc; b.st[1] = nx; }
        const unsigned old = xb_add(&bar[XB_XSUB(b.x)], 1u);
        const unsigned gen = old / nloc;
        if (old + 1u == (gen + 1u) * nloc) {
            __builtin_amdgcn_fence(__ATOMIC_RELEASE, "agent");
            asm volatile("s_waitcnt vmcnt(0)" ::: "memory");
            const unsigned og = xb_add(&bar[XB_TOP], 1u);
            const unsigned tg = og / nx;
            if (og + 1u == (tg + 1u) * nx) xb_add(&bar[XB_TOPGEN], 1u);
            else XB_SPIN(xb_ld(&bar[XB_TOPGEN]) == tg, bar);
            __builtin_amdgcn_fence(__ATOMIC_ACQUIRE, "agent");
            xb_add(&bar[XB_XGEN(b.x)], 1u);
            asm volatile("s_waitcnt vmcnt(0)" ::: "memory");
        } else {
            XB_SPIN(xb_ld(&bar[XB_XGEN(b.x)]) == gen, bar);
            __builtin_amdgcn_fence(__ATOMIC_ACQUIRE, "agent");
            asm volatile("s_waitcnt vmcnt(0)" ::: "memory");
        }
    }
    __syncthreads();
}

namespace pg8 {
using ::Params;

__device__ __forceinline__ int mod_row(int r) { return r < NPR ? (r >> 13) : 2 + ((r - NPR) >> 2); }

struct EpiProj {
    static constexpr bool PERM = true, AFTER_DRAIN = false;
    const Params* P;
    __device__ __forceinline__ void operator()(const f32x4 (&acc)[2][2][4][2], const Unit& u, int wr, int wc, int fr, int fq) const {
        asm volatile("" : "+v"(fr), "+v"(fq));
        const int G = u.pn * 4 + wc;
        if (G > 48) return;
        unsigned char* ws = P->ws; LAUNDER_GPTR(ws); float* out = P->out;
        const bool samp = u.pm >= 64;
        const int dd0 = 8 * fq;
        const int kind6 = (G - 24) >> 2, gk = (G - 24) & 3;
        const bool isnr = (G >= 16 && G < 24) || (G >= 24 && G < 48 && (kind6 & 1) == 0);
        const float* gain = nullptr;
        if (G >= 8 && G < 16) gain = P->in[16] + (G - 8) * 64;
        else if (G >= 16 && G < 24) gain = P->in[19];
        else if (isnr) gain = P->in[20 + (kind6 >> 1)];
        const float* rope = (const float*)(ws + WS_ROPE);
#pragma unroll
        for (int ai = 0; ai < 2; ++ai)
#pragma unroll
            for (int m = 0; m < 4; ++m) {
                const int r = u.pm * 256 + ai * 128 + wr * 64 + m * 16 + fr;
                const int s = r - NPR;
                const int b = r >> 13, t = r & 8191;
                const int pos = samp ? PAST + (s & 3) : t;
                f32x4 v[2][2];
#pragma unroll
                for (int bj = 0; bj < 2; ++bj)
#pragma unroll
                    for (int n = 0; n < 2; ++n) v[bj][n] = acc[ai][bj][m][n];
                if (G < 8) {
                    bf16_t* U = (bf16_t*)(ws + WS_U) + (size_t)r * 512 + G * 64 + dd0;
#pragma unroll
                    for (int bj = 0; bj < 2; ++bj) { u32x4 w;
                        w.x = cvt_pk_bf16(geluf_(v[bj][0][0]), geluf_(v[bj][0][1])); w.y = cvt_pk_bf16(geluf_(v[bj][0][2]), geluf_(v[bj][0][3]));
                        w.z = cvt_pk_bf16(geluf_(v[bj][1][0]), geluf_(v[bj][1][1])); w.w = cvt_pk_bf16(geluf_(v[bj][1][2]), geluf_(v[bj][1][3]));
                        *(u32x4*)(U + 32 * bj) = w; }
                } else if (G < 16) {
                    float ss = 0.f;
#pragma unroll
                    for (int bj = 0; bj < 2; ++bj)
#pragma unroll
                        for (int n = 0; n < 2; ++n)
#pragma unroll
                            for (int i = 0; i < 4; ++i) { const float g_ = geluf_(v[bj][n][i]); v[bj][n][i] = g_; ss += g_ * g_; }
                    ss += __shfl_xor(ss, 16); ss += __shfl_xor(ss, 32);
                    const float rstd = 1.0f / sqrtf(ss * (1.f / 64.f) + EPS);
                    bf16_t* V = (bf16_t*)(ws + WS_V) + (size_t)r * 512 + (G - 8) * 64 + dd0;
                    float* cv = nullptr;
                    if (samp) cv = out + O_SCV + (size_t)s * 512 + (G - 8) * 64 + dd0;
                    else if (t >= SEQ - 128) cv = out + O_PCV + ((size_t)b * 128 + (t - (SEQ - 128))) * 512 + (G - 8) * 64 + dd0;
#pragma unroll
                    for (int bj = 0; bj < 2; ++bj) { const f32x4 g0_ = *(const f32x4*)(gain + 32 * bj + dd0), g1_ = *(const f32x4*)(gain + 32 * bj + dd0 + 4); f32x4 a = v[bj][0] * rstd * g0_, c = v[bj][1] * rstd * g1_; u32x4 w;
                        w.x = cvt_pk_bf16(a[0], a[1]); w.y = cvt_pk_bf16(a[2], a[3]); w.z = cvt_pk_bf16(c[0], c[1]); w.w = cvt_pk_bf16(c[2], c[3]);
                        *(u32x4*)(V + 32 * bj) = w;
                        if (cv) { *(f32x4*)(cv + 32 * bj) = a; *(f32x4*)(cv + 32 * bj + 4) = c; } }
                } else if (G < 48) {
                    if (isnr) {
                        float ss = 0.f;
#pragma unroll
                        for (int bj = 0; bj < 2; ++bj)
#pragma unroll
                            for (int n = 0; n < 2; ++n)
#pragma unroll
                                for (int i = 0; i < 4; ++i) ss += v[bj][n][i] * v[bj][n][i];
                        ss += __shfl_xor(ss, 16); ss += __shfl_xor(ss, 32);
                        const float rstd = 1.0f / sqrtf(ss * (1.f / 64.f) + EPS);
                        const float* rp = rope + (size_t)pos * 64 + dd0;
#pragma unroll
                        for (int n = 0; n < 2; ++n) { const f32x4 cs = *(const f32x4*)(rp + 4 * n), sn = *(const f32x4*)(rp + 32 + 4 * n);
                            const f32x4 x1 = v[0][n] * rstd * *(const f32x4*)(gain + dd0 + 4 * n), x2 = v[1][n] * rstd * *(const f32x4*)(gain + 32 + dd0 + 4 * n);
                            v[0][n] = x1 * cs - x2 * sn; v[1][n] = x2 * cs + x1 * sn; }
                    }
                    if (G < 24) {
                        bf16_t* Q = (bf16_t*)(ws + WS_Q) + (size_t)r * 512 + (G - 16) * 64 + dd0;
#pragma unroll
                        for (int bj = 0; bj < 2; ++bj) { const f32x4 a = v[bj][0] * C2, c = v[bj][1] * C2; u32x4 w;
                            w.x = cvt_pk_bf16(a[0], a[1]); w.y = cvt_pk_bf16(a[2], a[3]); w.z = cvt_pk_bf16(c[0], c[1]); w.w = cvt_pk_bf16(c[2], c[3]);
                            *(u32x4*)(Q + 32 * bj) = w; }
                    } else {
                        float* o32 = nullptr; bf16_t* hm = nullptr;
                        const int rr = samp ? s : r;
                        const int sg = samp ? ((s >> 2) * 4 + gk) : 0, si = s & 3;
                        const size_t pofs = ((size_t)(b * 4 + gk) * SEQ + t) * 64;
                        switch (kind6) {
                        case 0: o32 = out + (samp ? O_SKC : O_PKC) + ((size_t)rr * 4 + gk) * 64; if (!samp) hm = (bf16_t*)(ws + WS_AK) + pofs; break;
                        case 1: o32 = out + (samp ? O_SVC : O_PVC) + ((size_t)rr * 4 + gk) * 64; if (!samp) hm = (bf16_t*)(ws + WS_AV) + pofs; break;
                        case 2: o32 = out + (samp ? O_SKS : O_PKS) + ((size_t)rr * 4 + gk) * 64;
                                hm = samp ? (bf16_t*)(ws + WS_CKS) + ((size_t)sg * 64 + si) * 64 : (bf16_t*)(ws + WS_KS) + pofs; break;
                        case 3: o32 = out + (samp ? O_SVS : O_PVS) + ((size_t)rr * 4 + gk) * 64;
                                hm = samp ? (bf16_t*)(ws + WS_CVS) + ((size_t)sg * 64 + si) * 64 : (bf16_t*)(ws + WS_VS) + pofs; break;
                        case 4: if (samp) o32 = out + O_SKW + (((size_t)(s >> 2) * 512 + 508 + si) * 4 + gk) * 64;
                                else if (t >= SEQ - 512) o32 = out + O_PKW + (((size_t)b * 512 + (t - (SEQ - 512))) * 4 + gk) * 64;
                                hm = samp ? (bf16_t*)(ws + WS_CWK) + ((size_t)sg * 64 + si) * 64 : (bf16_t*)(ws + WS_KW) + pofs; break;
                        default: if (samp) o32 = out + O_SVW + (((size_t)(s >> 2) * 512 + 508 + si) * 4 + gk) * 64;
                                else if (t >= SEQ - 512) o32 = out + O_PVW + (((size_t)b * 512 + (t - (SEQ - 512))) * 4 + gk) * 64;
                                hm = samp ? (bf16_t*)(ws + WS_CWV) + ((size_t)sg * 64 + si) * 64 : (bf16_t*)(ws + WS_VW) + pofs; break;
                        }
#pragma unroll
                        for (int bj = 0; bj < 2; ++bj) {
                            if (o32) { *(f32x4*)(o32 + 32 * bj + dd0) = v[bj][0]; *(f32x4*)(o32 + 32 * bj + dd0 + 4) = v[bj][1]; }
                            if (hm) { u32x4 w; w.x = cvt_pk_bf16(v[bj][0][0], v[bj][0][1]); w.y = cvt_pk_bf16(v[bj][0][2], v[bj][0][3]);
                                w.z = cvt_pk_bf16(v[bj][1][0], v[bj][1][1]); w.w = cvt_pk_bf16(v[bj][1][2], v[bj][1][3]);
                                *(u32x4*)(hm + 32 * bj + dd0) = w; } }
                    }
                } else {
                    if (fq < 3) { float* gt = (float*)(ws + WS_GATES) + (size_t)r * 24 + dd0;
#pragma unroll
                        for (int n = 0; n < 2; ++n) { f32x4 o; o[0] = sigmoidf_(v[0][n][0]); o[1] = sigmoidf_(v[0][n][1]); o[2] = sigmoidf_(v[0][n][2]); o[3] = sigmoidf_(v[0][n][3]);
                            *(f32x4*)(gt + 4 * n) = o; } }
                }
            }
    }
};

template <int WHICH> struct EpiResid {
    static constexpr bool PERM = true, AFTER_DRAIN = false;
    const Params* P;
    __device__ __forceinline__ void operator()(const f32x4 (&acc)[2][2][4][2], const Unit& u, int wr, int wc, int fr, int fq) const {
        unsigned char* ws = P->ws; LAUNDER_GPTR(ws);
        const float* MOD = (const float*)(ws + WS_MOD);
        float* X1 = (float*)(ws + WS_X1);
        const int col0 = u.pn * 256 + wc * 32 + 8 * fq;
#pragma unroll
        for (int ai = 0; ai < 2; ++ai)
#pragma unroll
            for (int m = 0; m < 4; ++m) {
                const int r = u.pm * 256 + ai * 128 + wr * 64 + m * 16 + fr;
                const float* gate = MOD + (size_t)mod_row(r) * 6144 + (WHICH == 0 ? 2048 : 5120) + col0;
                const float* res = (WHICH == 0) ? (r < NPR ? P->in[0] + (size_t)r * DM : P->in[1] + (size_t)(r - NPR) * DM) + col0 : X1 + (size_t)r * DM + col0;
                float* dst = (WHICH == 0) ? X1 + (size_t)r * DM + col0 : P->out + (size_t)r * DM + col0;
#pragma unroll
                for (int bj = 0; bj < 2; ++bj)
#pragma unroll
                    for (int n = 0; n < 2; ++n) { const int o = bj * 128 + 4 * n;
                        const f32x4 g = *(const f32x4*)(gate + o), x = *(const f32x4*)(res + o);
                        *(f32x4*)(dst + o) = x + g * acc[ai][bj][m][n]; }
            }
    }
};

struct EpiSwiglu {
    static constexpr bool PERM = true, AFTER_DRAIN = false;
    const Params* P;
    __device__ __forceinline__ void operator()(const f32x4 (&acc)[2][2][4][2], const Unit& u, int wr, int wc, int fr, int fq) const {
        bf16_t* F = (bf16_t*)(P->ws + WS_F);
        const int col0 = u.pn * 128 + wc * 32 + 8 * fq;
#pragma unroll
        for (int ai = 0; ai < 2; ++ai)
#pragma unroll
            for (int m = 0; m < 4; ++m) {
                const int r = u.pm * 256 + ai * 128 + wr * 64 + m * 16 + fr;
                const f32x4 a0 = acc[ai][0][m][0], a1 = acc[ai][0][m][1], b0 = acc[ai][1][m][0], b1 = acc[ai][1][m][1];
                u32x4 w;
                w.x = cvt_pk_bf16(siluf_(a0[0]) * b0[0], siluf_(a0[1]) * b0[1]); w.y = cvt_pk_bf16(siluf_(a0[2]) * b0[2], siluf_(a0[3]) * b0[3]);
                w.z = cvt_pk_bf16(siluf_(a1[0]) * b1[0], siluf_(a1[1]) * b1[1]); w.w = cvt_pk_bf16(siluf_(a1[2]) * b1[2], siluf_(a1[3]) * b1[3]);
                *(u32x4*)(F + (size_t)r * DFF + col0) = w;
            }
    }
};

struct EpiCmp {
    static constexpr bool PERM = true, AFTER_DRAIN = false;
    bf16_t* HIDK; bf16_t* HIDV; const float* bias;
    __device__ __forceinline__ void operator()(const f32x4 (&acc)[2][2][4][2], const Unit& u, int wr, int wc, int fr, int fq) const {
        asm volatile("" : "+v"(fr), "+v"(fq));
        const int col0 = wc * 32 + 8 * fq;
        bf16_t* HID = u.kind ? HIDV : HIDK;
        f32x4 bv[2][2];
#pragma unroll
        for (int bj = 0; bj < 2; ++bj)
#pragma unroll
            for (int n = 0; n < 2; ++n) bv[bj][n] = *(const f32x4*)(bias + u.kind * 256 + col0 + bj * 128 + 4 * n);
#pragma unroll
        for (int ai = 0; ai < 2; ++ai)
#pragma unroll
            for (int m = 0; m < 4; ++m) {
                const int r = u.pm * 256 + ai * 128 + wr * 64 + m * 16 + fr;
#pragma unroll
                for (int bj = 0; bj < 2; ++bj) { const f32x4 a = acc[ai][bj][m][0] + bv[bj][0], c = acc[ai][bj][m][1] + bv[bj][1]; u32x4 w;
                    w.x = cvt_pk_bf16(geluf_(a[0]), geluf_(a[1])); w.y = cvt_pk_bf16(geluf_(a[2]), geluf_(a[3]));
                    w.z = cvt_pk_bf16(geluf_(c[0]), geluf_(c[1])); w.w = cvt_pk_bf16(geluf_(c[2]), geluf_(c[3]));
                    *(u32x4*)(HID + (size_t)r * 256 + col0 + bj * 128) = w; }
            }
    }
};
template <int MODE> struct CmpOrder {
    const char* ak; const char* av; const char* bk; const char* bv; int G, c;
    __device__ __forceinline__ const char* abase(const Gemm&, const Unit& u) const { return ak + (ptrdiff_t)u.kind * (av - ak) + (size_t)u.pm * ((size_t)BM * 1024 * 2); }
    __device__ __forceinline__ const char* bbase(const Gemm&, const Unit& u) const { return bk + (ptrdiff_t)u.kind * (bv - bk); }
    __device__ __forceinline__ bool next(int i, Unit& u) const {
        const int L = i * G + c; u.pn = 0;
        if (MODE == 0) { if (L >= 512) return false; u.kind = L >> 8; u.pm = 16 + (L & 255); return true; }
        if (L >= 32) return false; u.kind = L >> 4; u.pm = L & 15; return true;
    }
    __device__ __forceinline__ void a_ready(const Unit&) const {}
    __device__ __forceinline__ void done(const Unit&) const {}
};
}
struct Ctx { LAS unsigned char* lds; int tid, lane, wave, nblk, blk; };

__device__ __forceinline__ unsigned pk2(float lo, float hi) { return cvt_pk_bf16(lo, hi); }

__device__ __forceinline__ void transpose_item(const float* W, int K, int N, bf16_t* WT, int orow0, int n0, int kb, LAS float* scr, int lane) {
    const int k0 = 64 * kb;
    { float x[32]; const int n = n0 + (lane & 31); const float* wp = W + (size_t)k0 * N; const unsigned lo = (unsigned)((lane >> 5) * N + n);
#pragma unroll
      for (int i = 0; i < 32; ++i) x[i] = (n < N) ? (wp + (size_t)(2 * i) * N)[lo] : 0.f;
#pragma unroll
      for (int i = 0; i < 32; ++i) scr[(2 * i + (lane >> 5)) * 33 + (lane & 31)] = x[i]; }
    LDS_WAIT(); asm volatile("" ::: "memory");
    const int c = lane & 7;
#pragma unroll
    for (int j = 0; j < 4; ++j) { const int n = (lane >> 3) + 8 * j; const LAS float* s = scr + (8 * c) * 33 + n;
        u32x4 o; o.x = pk2(s[0 * 33], s[1 * 33]); o.y = pk2(s[2 * 33], s[3 * 33]); o.z = pk2(s[4 * 33], s[5 * 33]); o.w = pk2(s[6 * 33], s[7 * 33]);
        *(u32x4*)(WT + (size_t)(orow0 + n) * K + k0 + 8 * c) = o; }
    LDS_WAIT(); asm volatile("" ::: "memory");
}

#define MFMA32(a, b, c) __builtin_amdgcn_mfma_f32_32x32x16_bf16(a, b, c, 0, 0, 0)
__device__ __forceinline__ void phase_prologue(const Params& P, const Ctx& C, int parts) {
    unsigned char* ws = P.ws; LAUNDER_GPTR(ws); float* out = P.out;
    const int lane = fresh_lane(), wave = C.wave, tid = wave * 64 + lane;
    if (parts & 1)
    for (int item = C.blk; item < 192; item += C.nblk) {
        const int n0 = item * 32, r32 = lane & 31, hi = lane >> 5;
        LAS float* R = (LAS float*)C.lds;
        f32x16 acc[5];
#pragma unroll
        for (int rt = 0; rt < 5; ++rt) acc[rt] = (f32x16){0.f, 0.f, 0.f, 0.f, 0.f, 0.f, 0.f, 0.f, 0.f, 0.f, 0.f, 0.f, 0.f, 0.f, 0.f, 0.f};
        const float* wcol = P.in[11] + n0 + r32;
#pragma unroll 2
        for (int ks = 0; ks < 8; ++ks) {
            const int k0 = wave * 128 + ks * 16 + 8 * hi;
            float wv[8];
#pragma unroll
            for (int i = 0; i < 8; ++i) wv[i] = wcol[(size_t)(k0 + i) * 6144];
            f32x4 cv[5][2];
#pragma unroll
            for (int rt = 0; rt < 5; ++rt) { const int r = rt * 32 + r32;
                const float* cp = (r < 2) ? P.in[9] + r * 1024 + k0 : P.in[10] + (size_t)((r < 130 ? r : 2) - 2) * 1024 + k0;
                cv[rt][0] = *(const f32x4*)cp; cv[rt][1] = *(const f32x4*)(cp + 4);
                if (r >= 130) { cv[rt][0] = (f32x4){0.f, 0.f, 0.f, 0.f}; cv[rt][1] = cv[rt][0]; } }
            u32x4 bh, bl;
#pragma unroll
            for (int p = 0; p < 4; ++p) { const float x0 = wv[2 * p], x1 = wv[2 * p + 1]; const unsigned h = cvt_pk_bf16(x0, x1);
                bh[p] = h; bl[p] = cvt_pk_bf16(x0 - __uint_as_float(h << 16), x1 - __uint_as_float(h & 0xffff0000u)); }
#pragma unroll
            for (int rt = 0; rt < 5; ++rt) { u32x4 ah, al;
#pragma unroll
                for (int p = 0; p < 4; ++p) { const float x0 = siluf_(cv[rt][p >> 1][2 * (p & 1)]), x1 = siluf_(cv[rt][p >> 1][2 * (p & 1) + 1]); const unsigned h = cvt_pk_bf16(x0, x1);
                    ah[p] = h; al[p] = cvt_pk_bf16(x0 - __uint_as_float(h << 16), x1 - __uint_as_float(h & 0xffff0000u)); }
                acc[rt] = MFMA32(__builtin_bit_cast(bf16x8, ah), __builtin_bit_cast(bf16x8, bh), acc[rt]);
                acc[rt] = MFMA32(__builtin_bit_cast(bf16x8, ah), __builtin_bit_cast(bf16x8, bl), acc[rt]);
                acc[rt] = MFMA32(__builtin_bit_cast(bf16x8, al), __builtin_bit_cast(bf16x8, bh), acc[rt]); }
        }
        __syncthreads();
        if (wave >= 4) {
#pragma unroll
            for (int rt = 0; rt < 5; ++rt)
#pragma unroll
                for (int r = 0; r < 16; ++r) R[((wave - 4) * 80 + rt * 16 + r) * 64 + lane] = acc[rt][r]; }
        __syncthreads();
        if (wave < 4) {
#pragma unroll
            for (int rt = 0; rt < 5; ++rt)
#pragma unroll
                for (int r = 0; r < 16; ++r) R[(wave * 80 + rt * 16 + r) * 64 + lane] += acc[rt][r]; }
        __syncthreads();
        for (int o = tid; o < 80 * 64; o += 512) { const int idx = o >> 6, ln = o & 63, r = idx & 15;
            const int row = (idx >> 4) * 32 + (r & 3) + 8 * (r >> 2) + 4 * (ln >> 5), col = n0 + (ln & 31);
            if (row < 130) ((float*)(ws + WS_MOD))[(size_t)row * 6144 + col] = ((R[idx * 64 + ln] + R[(80 + idx) * 64 + ln]) + (R[(160 + idx) * 64 + ln] + R[(240 + idx) * 64 + ln])) + P.in[12][col]; }
    }
    __syncthreads();
    if (parts & 2) {
        LAS float* scr = (LAS float*)(C.lds + wave * 16384);
        const int gw = C.blk * NWAVES + wave, NGW = C.nblk * NWAVES;
        constexpr int I_IN = 16 * 104, I_OUT = 16 * 32, I_F1 = 16 * 176, I_F2 = 44 * 32, I_C1 = 32 * 8, I_W2 = 4 * 2;
        constexpr int NIT = I_IN + I_OUT + I_F1 + I_F2 + 2 * I_C1 + 2 * I_W2;
        for (int it = gw; it < NIT; it += NGW) {
            int r = it;
            if (r < I_IN) { const int kb = r / 104, nb = r % 104, n0 = 32 * nb, pn = n0 >> 8, wi = n0 & 255, wcq = wi >> 6, bjq = (wi & 63) >> 5;
                transpose_item(P.in[15], 1024, INC, (bf16_t*)(ws + WS_WTIN), 256 * pn + 128 * bjq + 32 * wcq, n0, kb, scr, lane); continue; } r -= I_IN;
            if (r < I_OUT) { transpose_item(P.in[29], 1024, 1024, (bf16_t*)(ws + WS_WTOUT), 32 * (r % 32), 32 * (r % 32), r / 32, scr, lane); continue; } r -= I_OUT;
            if (r < I_F1) { const int kb = r / 176, pg = r % 176, p0 = 32 * pg, pn = p0 >> 8, pp = p0 & 255, bj = pp >> 7, rest = pp & 127;
                transpose_item(P.in[30], 1024, 2 * DFF, (bf16_t*)(ws + WS_WTF1), p0, (bj ? DFF : 0) + 128 * pn + rest, kb, scr, lane); continue; } r -= I_F1;
            if (r < I_F2) { transpose_item(P.in[31], DFF, 1024, (bf16_t*)(ws + WS_WTF2), 32 * (r % 32), 32 * (r % 32), r / 32, scr, lane); continue; } r -= I_F2;
            if (r < I_C1) { transpose_item(P.in[25], 2048, 256, (bf16_t*)(ws + WS_WTC1K), 32 * (r % 8), 32 * (r % 8), r / 8, scr, lane); continue; } r -= I_C1;
            if (r < I_C1) { transpose_item(P.in[27], 2048, 256, (bf16_t*)(ws + WS_WTC1V), 32 * (r % 8), 32 * (r % 8), r / 8, scr, lane); continue; } r -= I_C1;
            if (r < I_W2) { transpose_item(P.in[26], 256, 64, (bf16_t*)(ws + WS_W2TK), 32 * (r % 2), 32 * (r % 2), r / 2, scr, lane); continue; } r -= I_W2;
            transpose_item(P.in[28], 256, 64, (bf16_t*)(ws + WS_W2TV), 32 * (r % 2), 32 * (r % 2), r / 2, scr, lane);
        }
    }
    const int gt = C.blk * 512 + tid, NGT = C.nblk * 512;
    if (parts & 4) { float* rope = (float*)(ws + WS_ROPE);
      for (int e = gt; e < 8192 * 32; e += NGT) { const int pos = e >> 5, d = e & 31;
          const double inv = pow(10000.0, -(double)d / 32.0); const double ang = (double)pos * inv;
          rope[(size_t)pos * 64 + d] = (float)cos(ang); rope[(size_t)pos * 64 + 32 + d] = (float)sin(ang); } }
    if ((parts & 4) && C.blk == 0 && tid < 64) { float gq = fabsf(P.in[19][tid]), gk = fmaxf(fabsf(P.in[20][tid]), fmaxf(fabsf(P.in[21][tid]), fabsf(P.in[22][tid])));
#pragma unroll
        for (int o = 1; o < 64; o <<= 1) { gq = fmaxf(gq, __shfl_xor(gq, o)); gk = fmaxf(gk, __shfl_xor(gk, o)); }
        if (tid == 0) ((float*)(ws + WS_PEB))[768] = 64.f * gq * gk * C2 * 1.03f; }
    if (parts & 4) { bf16_t* sw = (bf16_t*)(ws + WS_SGUW);
      for (int e = gt; e < 8 * 128 * 128; e += NGT) { const int tt = (e >> 7) & 127, s = e & 127; const float w = (s <= tt) ? P.in[17][e] : 0.f; sw[e] = (bf16_t)(cvt_pk_bf16(w, 0.f) & 0xffffu); } }
    if (parts & 4) { const int gwv = C.blk * NWAVES + wave, NGWV = C.nblk * NWAVES;
      for (int it = gwv; it < 64; it += NGWV) { const int kv = it >> 5, kc = it & 31; const float* pe = P.in[23 + kv] + kc * 64; const float* w1 = P.in[25 + 2 * kv] + (size_t)(kc * 64) * 256; const unsigned lo4 = 4u * lane;
          f32x4 acc = {0.f, 0.f, 0.f, 0.f};
#pragma unroll 16
          for (int k = 0; k < 64; ++k) acc += *(const f32x4*)((w1 + (size_t)k * 256) + lo4) * pe[k];
          *(f32x4*)((float*)(ws + WS_PEB) + 1024 + (kv * 32 + kc) * 256 + 4 * lane) = acc; } }
    if (parts & 16) { const u32x4 z = {0u, 0u, 0u, 0u};
      for (int e = gt; e < 512 * 64 * 8; e += NGT) { *(u32x4*)((bf16_t*)(ws + WS_CKS) + (size_t)e * 8) = z; *(u32x4*)((bf16_t*)(ws + WS_CVS) + (size_t)e * 8) = z;
          *(u32x4*)((bf16_t*)(ws + WS_CWK) + (size_t)e * 8) = z; *(u32x4*)((bf16_t*)(ws + WS_CWV) + (size_t)e * 8) = z; }
      for (int e = gt; e < 1024; e += NGT) { *(u32x4*)((bf16_t*)(ws + WS_AK) + (size_t)NCROWS * 1024 + e * 8) = z; *(u32x4*)((bf16_t*)(ws + WS_AV) + (size_t)NCROWS * 1024 + e * 8) = z; } }
}


__device__ __forceinline__ void cache_convert(const Params& P, const Ctx& C) {
    unsigned char* ws = P.ws; LAUNDER_GPTR(ws); int lane_ = fresh_lane(); const int lane = lane_, wave = C.wave;
    { const int gwv = C.blk * NWAVES + wave, NGWV = C.nblk * NWAVES;
      for (int it = gwv; it < 2 * NSEQ * 16 * 4; it += NGWV) {
        const int qt = it & 3, sp = (it >> 2) & 2047, ci = it >> 13, seq = sp >> 4, pi = sp & 15;
        const int page = ((const int*)P.in[8])[seq * 16 + pi];
        const float* src = P.in[2 + ci] + (size_t)page * (128 * 256) + (size_t)qt * (32 * 256);
        bf16_t* dst = (bf16_t*)(ws + (ci ? WS_AV : WS_AK)) + 4194304;
        f32x4 a[16], c[16];
#pragma unroll
        for (int j = 0; j < 16; ++j) { const float* sj = src + (size_t)(64 * j) * 8; a[j] = *(const f32x4*)(sj + 8u * lane); c[j] = *(const f32x4*)(sj + 8u * lane + 4); }
#pragma unroll
        for (int j = 0; j < 16; ++j) { const int q = lane + 64 * j, posn = qt * 32 + (q >> 5), g = (q & 31) >> 3, d0 = (q & 7) * 8;
            u32x4 w; w.x = pk2(a[j][0], a[j][1]); w.y = pk2(a[j][2], a[j][3]); w.z = pk2(c[j][0], c[j][1]); w.w = pk2(c[j][2], c[j][3]);
            *(u32x4*)(dst + ((size_t)(seq * 4 + g) * TC + pi * 128 + posn) * 64 + d0) = w; }
      } }
    VM_WAIT();
    __syncthreads();
}

template <int WHICH> __device__ __forceinline__ void phase_modulate(const Params& P, const Ctx& C) {
    unsigned char* ws = P.ws; LAUNDER_GPTR(ws);
    const float* MOD = (const float*)(ws + WS_MOD);
    const float* gn = P.in[WHICH == 0 ? 13 : 14];
    bf16_t* H = (bf16_t*)(ws + WS_H);
    const int gw = C.blk * NWAVES + C.wave, NGW = C.nblk * NWAVES, lane = fresh_lane(), tid_c = C.wave * 64 + lane;
    if (WHICH == 0 && C.blk == 0) { float* peb = (float*)(ws + WS_PEB); float a = 0.f;
#pragma unroll
        for (int kc = 0; kc < 32; ++kc) a += peb[1024 + ((tid_c >> 8) * 32 + kc) * 256 + (tid_c & 255)];
        peb[tid_c] = a; }
    for (int r = gw; r < NR; r += NGW) {
        const float* xr = (WHICH == 0) ? (r < NPR ? P.in[0] + (size_t)r * DM : P.in[1] + (size_t)(r - NPR) * DM) : (const float*)(ws + WS_X1) + (size_t)r * DM;
        const float* mr = MOD + (size_t)pg8::mod_row(r) * 6144 + (WHICH == 0 ? 0 : 3072);
        f32x4 v[4]; float ss = 0.f;
#pragma unroll
        for (int j = 0; j < 4; ++j) { v[j] = *(const f32x4*)(xr + 4 * lane + 256 * j); ss += (v[j][0] * v[j][0] + v[j][1] * v[j][1]) + (v[j][2] * v[j][2] + v[j][3] * v[j][3]); }
        const float rstd = 1.0f / sqrtf(wave_sum(ss) * (1.f / DM) + EPS);
#pragma unroll
        for (int j = 0; j < 4; ++j) { const int c = 4 * lane + 256 * j;
            const f32x4 g = *(const f32x4*)(gn + c), sh = *(const f32x4*)(mr + c), sc = *(const f32x4*)(mr + 1024 + c);
            const f32x4 o = v[j] * rstd * g * (sc + 1.0f) + sh;
            u32x2 w; w.x = pk2(o[0], o[1]); w.y = pk2(o[2], o[3]);
            *(u32x2*)(H + (size_t)r * DM + c) = w; }
    }
}

#define F16Z_ {0.f, 0.f, 0.f, 0.f, 0.f, 0.f, 0.f, 0.f, 0.f, 0.f, 0.f, 0.f, 0.f, 0.f, 0.f, 0.f}
typedef short v4i16_t __attribute__((ext_vector_type(4)));
__device__ __forceinline__ s16x4 tr16(const LAS unsigned char* p) { return __builtin_bit_cast(s16x4, __builtin_amdgcn_ds_read_tr16_b64_v4i16((LAS v4i16_t*)p)); }
__device__ __forceinline__ bf16x8 cat8(s16x4 lo, s16x4 hi) { return (bf16x8){lo[0], lo[1], lo[2], lo[3], hi[0], hi[1], hi[2], hi[3]}; }

__device__ __forceinline__ void phase_chunk_mlp(const Params& P, const Ctx& C, int vb, int vn) {
    unsigned char* ws = P.ws; LAUNDER_GPTR(ws);
    const bf16_t* U = (const bf16_t*)(ws + WS_U); const bf16_t* V = (const bf16_t*)(ws + WS_V); bf16_t* MIX = (bf16_t*)(ws + WS_MIX);
    const bf16_t* SW = (const bf16_t*)(ws + WS_SGUW);
    int lane_ = fresh_lane();
    const int lane = lane_, wave = C.wave, tid = wave * 64 + lane, r32 = lane & 31, hi = lane >> 5;
    LAS unsigned char* vt = C.lds + wave * 16384;
    for (int un = vb * NWAVES + wave; un < 2 * 64 * 8; un += vn * NWAVES) {
        const int g = un & 7, ch = (un >> 3) & 63, b = un >> 9;
        const size_t row0 = (size_t)b * SEQ + ch * 128;
        LDS_WAIT();
        { u32x4 x[16]; const unsigned char* vsrc = (const unsigned char*)(V + (row0 + (lane >> 3)) * 512 + g * 64) + (lane & 7) * 16;
#pragma unroll
          for (int it = 0; it < 16; ++it) x[it] = *(const u32x4*)(vsrc + (size_t)(8 * it) * 1024);
#pragma unroll
          for (int it = 0; it < 16; ++it) *(LAS u32x4*)(vt + ((lane & 7) >> 2) * 8192 + (8 * it + (lane >> 3)) * 64 + (lane & 3) * 16) = x[it]; }
        LDS_WAIT();
        const LAS unsigned char* vb0 = vt + ((lane >> 4) & 1) * 32 + (lane & 3) * 8 + (8 * hi + ((lane & 15) >> 2)) * 64;
#pragma unroll
        for (int tb = 0; tb < 4; ++tb) {
            const int t = 32 * tb + r32;
            const bf16_t* wrow = SW + ((size_t)g * 128 + t) * 128 + 8 * hi;
            bf16x8 wf[8];
#pragma unroll
            for (int ks = 0; ks < 2 * tb + 2; ++ks) wf[ks] = *(const bf16x8*)(wrow + 16 * ks);
            const float bs = P.in[18][g * 128 + t];
            const size_t ro = row0 + t;
            u32x2 ug0[4], ug1[4];
#pragma unroll
            for (int rq = 0; rq < 4; ++rq) { const int d0 = 8 * rq + 4 * hi; ug0[rq] = *(const u32x2*)(U + ro * 512 + g * 64 + d0); ug1[rq] = *(const u32x2*)(U + ro * 512 + g * 64 + 32 + d0); }
            f32x16 acc0 = F16Z_, acc1 = F16Z_;
#pragma unroll
            for (int ks = 0; ks < 2 * tb + 2; ++ks) {
                const bf16x8 v0 = cat8(tr16(vb0 + ks * 1024), tr16(vb0 + ks * 1024 + 256));
                const bf16x8 v1 = cat8(tr16(vb0 + 8192 + ks * 1024), tr16(vb0 + 8192 + ks * 1024 + 256));
                acc0 = MFMA32(v0, wf[ks], acc0); acc1 = MFMA32(v1, wf[ks], acc1); }
#pragma unroll
            for (int rq = 0; rq < 4; ++rq) { const int d0 = 8 * rq + 4 * hi;
                const u32x2 u0 = ug0[rq], u1 = ug1[rq];
                u32x2 w; w.x = pk2(bflo(u0.x) * (acc0[4 * rq] + bs), bfhi(u0.x) * (acc0[4 * rq + 1] + bs)); w.y = pk2(bflo(u0.y) * (acc0[4 * rq + 2] + bs), bfhi(u0.y) * (acc0[4 * rq + 3] + bs));
                *(u32x2*)(MIX + ro * 1024 + g * 64 + d0) = w;
                w.x = pk2(bflo(u1.x) * (acc1[4 * rq] + bs), bfhi(u1.x) * (acc1[4 * rq + 1] + bs)); w.y = pk2(bflo(u1.y) * (acc1[4 * rq + 2] + bs), bfhi(u1.y) * (acc1[4 * rq + 3] + bs));
                *(u32x2*)(MIX + ro * 1024 + g * 64 + 32 + d0) = w; }
        }
    }
    const int gt = vb * 512 + tid, NGT = vn * 512;
    for (int e = gt; e < NSEQ * 4 * 512; e += NGT) { const int col = e & 511, tt = (e >> 9) & 3, seq = e >> 11, g = col >> 6;
        float a = P.in[18][g * 128 + tt];
        for (int s = 0; s <= tt; ++s) a += P.in[17][(g * 128 + tt) * 128 + s] * bf2f(V[((size_t)NPR + seq * 4 + s) * 512 + col]);
        const size_t r = (size_t)NPR + seq * 4 + tt;
        MIX[r * 1024 + col] = (bf16_t)(pk2(bf2f(U[r * 512 + col]) * a, 0.f) & 0xffffu); }
}

__device__ __forceinline__ void phase_cmp2(const Params& P, const Ctx& C) {
    unsigned char* ws = P.ws; LAUNDER_GPTR(ws);
    const int lane = fresh_lane(), r32 = lane & 31, hi = lane >> 5;
    const int gw = C.blk * NWAVES + C.wave, NGW = C.nblk * NWAVES;
    constexpr int NI = NCROWS / 32;
    for (int it = gw; it < 2 * NI; it += NGW) {
        const int kv = it >= NI, row0 = (kv ? it - NI : it) * 32;
        const bf16_t* HID = (const bf16_t*)(ws + (kv ? WS_HIDV : WS_HIDK)) + (size_t)(row0 + r32) * 256 + 8 * hi;
        const bf16_t* W2T = (const bf16_t*)(ws + (kv ? WS_W2TV : WS_W2TK)) + (size_t)r32 * 256 + 8 * hi;
        f32x16 a0 = F16Z_, a1 = a0;
#pragma unroll 4
        for (int ks = 0; ks < 16; ++ks) { const bf16x8 hf = *(const bf16x8*)(HID + 16 * ks);
            a0 = MFMA32(*(const bf16x8*)(W2T + 16 * ks), hf, a0); a1 = MFMA32(*(const bf16x8*)(W2T + 32 * 256 + 16 * ks), hf, a1); }
        bf16_t* O = (bf16_t*)(ws + (kv ? WS_VCC : WS_KCC)) + (size_t)(row0 + r32) * 64;
#pragma unroll
        for (int rq = 0; rq < 4; ++rq) { u32x2 w;
            w.x = pk2(a0[4 * rq], a0[4 * rq + 1]); w.y = pk2(a0[4 * rq + 2], a0[4 * rq + 3]); *(u32x2*)(O + 8 * rq + 4 * hi) = w;
            w.x = pk2(a1[4 * rq], a1[4 * rq + 1]); w.y = pk2(a1[4 * rq + 2], a1[4 * rq + 3]); *(u32x2*)(O + 32 + 8 * rq + 4 * hi) = w; }
    }
}

__device__ __forceinline__ void cmp2_tile(const Params& P, const Ctx& C, int kv, int pm) {
    unsigned char* ws = P.ws; LAUNDER_GPTR(ws);
    const int lane = fresh_lane(), r32 = lane & 31, hi = lane >> 5;
    const int row0 = pm * 256 + 32 * C.wave;
    const bf16_t* HID = (const bf16_t*)(ws + (kv ? WS_HIDV : WS_HIDK)) + (size_t)(row0 + r32) * 256 + 8 * hi;
    const bf16_t* W2T = (const bf16_t*)(ws + (kv ? WS_W2TV : WS_W2TK)) + (size_t)r32 * 256 + 8 * hi;
    f32x16 a0 = F16Z_, a1 = a0;
#pragma unroll 8
    for (int ks = 0; ks < 16; ++ks) { const bf16x8 hf = *(const bf16x8*)(HID + 16 * ks);
        a0 = MFMA32(*(const bf16x8*)(W2T + 16 * ks), hf, a0); a1 = MFMA32(*(const bf16x8*)(W2T + 32 * 256 + 16 * ks), hf, a1); }
    bf16_t* O = (bf16_t*)(ws + (kv ? WS_VCC : WS_KCC)) + (size_t)(row0 + r32) * 64;
#pragma unroll
    for (int rq = 0; rq < 4; ++rq) { u32x2 w;
        w.x = pk2(a0[4 * rq], a0[4 * rq + 1]); w.y = pk2(a0[4 * rq + 2], a0[4 * rq + 3]); *(u32x2*)(O + 8 * rq + 4 * hi) = w;
        w.x = pk2(a1[4 * rq], a1[4 * rq + 1]); w.y = pk2(a1[4 * rq + 2], a1[4 * rq + 3]); *(u32x2*)(O + 32 + 8 * rq + 4 * hi) = w; }
}

template <int WHICH> __device__ __forceinline__ void sample_rows_gemm(const Params& P, const Ctx& C) {
    unsigned char* ws = P.ws; LAUNDER_GPTR(ws);
    constexpr int K = (WHICH == 0) ? DM : DFF, KE = K / 8;
    const bf16_t* ACT = (const bf16_t*)(ws + (WHICH == 0 ? WS_MIX : WS_F)); const bf16_t* WT = (const bf16_t*)(ws + (WHICH == 0 ? WS_WTOUT : WS_WTF2));
    int lane_ = fresh_lane();
    const int lane = lane_, wave = C.wave, r32 = lane & 31, hi = lane >> 5;
    LAS float* R = (LAS float*)C.lds;
    for (int pc = C.blk; pc < 256; pc += C.nblk) {
        const int rb = pc >> 4, cb = pc & 15;
        const int m = NPR + rb * 32 + r32;
        const bf16_t* wp = WT + (size_t)(cb * 64 + r32) * K + wave * KE + 8 * hi; const bf16_t* ap = ACT + (size_t)m * K + wave * KE + 8 * hi;
        f32x16 acc0 = F16Z_, acc1 = F16Z_;
#pragma unroll (WHICH == 0 ? 8 : 11)
        for (int ks = 0; ks < KE / 16; ++ks) { const bf16x8 af = *(const bf16x8*)(ap + 16 * ks);
            acc0 = MFMA32(*(const bf16x8*)(wp + 16 * ks), af, acc0); acc1 = MFMA32(*(const bf16x8*)(wp + (size_t)32 * K + 16 * ks), af, acc1); }
        __syncthreads();
#pragma unroll
        for (int r = 0; r < 16; ++r) { R[((wave * 2 + 0) * 16 + r) * 64 + lane] = acc0[r]; R[((wave * 2 + 1) * 16 + r) * 64 + lane] = acc1[r]; }
        __syncthreads();
        if (wave < 2) { const int nb = wave; f32x16 acc;
#pragma unroll
            for (int r = 0; r < 16; ++r) { float s = R[((0 * 2 + nb) * 16 + r) * 64 + lane];
#pragma unroll
                for (int w8 = 1; w8 < 8; ++w8) s += R[((w8 * 2 + nb) * 16 + r) * 64 + lane];
                acc[r] = s; }
            const float* MOD = (const float*)(ws + WS_MOD) + (size_t)pg8::mod_row(m) * 6144 + (WHICH == 0 ? 2048 : 5120);
            const float* res = (WHICH == 0) ? P.in[1] + (size_t)(m - NPR) * DM : (const float*)(ws + WS_X1) + (size_t)m * DM;
            float* dst = (WHICH == 0) ? (float*)(ws + WS_X1) + (size_t)m * DM : P.out + (size_t)m * DM;
#pragma unroll
            for (int rq = 0; rq < 4; ++rq) { const int c0 = cb * 64 + nb * 32 + 8 * rq + 4 * hi;
                const f32x4 a = {acc[4 * rq], acc[4 * rq + 1], acc[4 * rq + 2], acc[4 * rq + 3]};
                *(f32x4*)(dst + c0) = *(const f32x4*)(res + c0) + *(const f32x4*)(MOD + c0) * a; }
        }
    }
    __syncthreads();
}
#define F16Z {0.f, 0.f, 0.f, 0.f, 0.f, 0.f, 0.f, 0.f, 0.f, 0.f, 0.f, 0.f, 0.f, 0.f, 0.f, 0.f}
constexpr float NEG_INF = -__builtin_inff();

__device__ __forceinline__ void qk_tile_sw(const LAS unsigned char* kb, const bf16x8 (&qr)[4], f32x16& s0, f32x16& s1, int r32, int hi) {
    f32x16 a = {0.f, 0.f, 0.f, 0.f, 0.f, 0.f, 0.f, 0.f, 0.f, 0.f, 0.f, 0.f, 0.f, 0.f, 0.f, 0.f}, b = a;
    const LAS unsigned char* kp = kb + hi * 1024 + (r32 & ~7) * 16;
#pragma unroll
    for (int d0 = 0; d0 < 4; ++d0) { const int lo = (r32 + 2 * d0 + hi) & 7;
        const bf16x8 k0 = *(const LAS bf16x8*)(kp + d0 * 2048 + lo * 16), k1 = *(const LAS bf16x8*)(kp + d0 * 2048 + lo * 16 + 512);
        a = MFMA32(k0, qr[d0], a); b = MFMA32(k1, qr[d0], b);
    }
    s0 = a; s1 = b;
}
__device__ __forceinline__ void qk_tile(const LAS unsigned char* kb, const bf16x8 (&qr)[4], f32x16& s0, f32x16& s1, int r32, int hi) {
    const LAS unsigned char* kp = kb + hi * 1024 + r32 * 16;
    f32x16 a = F16Z, b = F16Z;
#pragma unroll
    for (int d0 = 0; d0 < 4; ++d0) {
        const bf16x8 k0 = *(const LAS bf16x8*)(kp + d0 * 2048), k1 = *(const LAS bf16x8*)(kp + d0 * 2048 + 512);
        a = MFMA32(k0, qr[d0], a); b = MFMA32(k1, qr[d0], b);
    }
    s0 = a; s1 = b;
}
__device__ __forceinline__ void mask_tile(f32x16& s0, f32x16& s1, int key0, int klo, int khi, bool en, int hi) {
#pragma unroll
    for (int r = 0; r < 16; ++r) { const int k = key0 + crow(r, hi);
        if (!(en && k >= klo && k <= khi)) s0[r] = NEG_INF;
        if (!(en && k + 32 >= klo && k + 32 <= khi)) s1[r] = NEG_INF; }
}
__device__ __forceinline__ float half_swap_max(float m) { auto rr = __builtin_amdgcn_permlane32_swap(__float_as_uint(m), __float_as_uint(m), false, false); return fmaxf(__uint_as_float(rr[0]), __uint_as_float(rr[1])); }
__device__ __forceinline__ float half_swap_sum(float m) { auto rr = __builtin_amdgcn_permlane32_swap(__float_as_uint(m), __float_as_uint(m), false, false); return __uint_as_float(rr[0]) + __uint_as_float(rr[1]); }
__device__ __forceinline__ float tile_max(const f32x16& s0, const f32x16& s1) {
    float m = fmaxf(s0[0], s1[0]);
#pragma unroll
    for (int r = 1; r < 16; ++r) m = fmaxf(m, fmaxf(s0[r], s1[r]));
    return half_swap_max(m);
}
__device__ __forceinline__ void stats_step(const f32x16& s0, const f32x16& s1, float& m_run, float& l_run) {
    const float mn = fmaxf(m_run, tile_max(s0, s1)); const float alpha = fast_exp2(m_run - mn); m_run = mn;
    float sum = 0.f;
#pragma unroll
    for (int r = 0; r < 16; ++r) sum += fast_exp2(s0[r] - mn) + fast_exp2(s1[r] - mn);
    l_run = l_run * alpha + sum;
}
__device__ __forceinline__ void softmax_step(f32x16& s0, f32x16& s1, float& m_run, float& l_run, f32x16& o0, f32x16& o1) {
    const float mn = fmaxf(m_run, tile_max(s0, s1)); const float alpha = fast_exp2(m_run - mn); m_run = mn;
    float sum = 0.f;
#pragma unroll
    for (int r = 0; r < 16; ++r) { s0[r] = fast_exp2(s0[r] - mn); s1[r] = fast_exp2(s1[r] - mn); sum += s0[r] + s1[r]; }
    l_run = l_run * alpha + sum;
    o0 = o0 * alpha; o1 = o1 * alpha;
}
__device__ __forceinline__ bf16x8 pack8(const f32x16& p, int o) {
    u32x4 w; w.x = cvt_pk_bf16(p[o], p[o + 1]); w.y = cvt_pk_bf16(p[o + 2], p[o + 3]); w.z = cvt_pk_bf16(p[o + 4], p[o + 5]); w.w = cvt_pk_bf16(p[o + 6], p[o + 7]);
    return __builtin_bit_cast(bf16x8, w);
}
__device__ __forceinline__ void pv_tile(const LAS unsigned char* vb, const f32x16& p0, const f32x16& p1, f32x16& o0, f32x16& o1, int lane, int hi) {
    const LAS unsigned char* vp = vb + ((lane >> 4) & 1) * 32 + (lane & 3) * 8 + (4 * hi + ((lane & 15) >> 2)) * 64;
#pragma unroll
    for (int kk = 0; kk < 4; ++kk) {
        const bf16x8 pf = (kk < 2) ? pack8(p0, 8 * kk) : pack8(p1, 8 * (kk - 2));
        const bf16x8 v0 = cat8(tr16(vp + kk * 1024), tr16(vp + kk * 1024 + 512));
        const bf16x8 v1 = cat8(tr16(vp + 4096 + kk * 1024), tr16(vp + 4096 + kk * 1024 + 512));
        o0 = MFMA32(v0, pf, o0); o1 = MFMA32(v1, pf, o1);
    }
}
__device__ __forceinline__ void tile_ld(const bf16_t* kt, const bf16_t* vt, int wave, int lane, u32x4& kr, u32x4& vr) {
    kr = *(const u32x4*)((const unsigned char*)kt + lane * 128 + wave * 16);
    vr = *(const u32x4*)((const unsigned char*)vt + (16 * (wave & 3) + (lane >> 2)) * 128 + (wave >> 2) * 64 + (lane & 3) * 16);
}
__device__ __forceinline__ void tile_st(LAS unsigned char* kb, LAS unsigned char* vb, int wave, int lane, const u32x4& kr, const u32x4& vr) {
    *(LAS u32x4*)(kb + wave * 1024 + lane * 16) = kr; *(LAS u32x4*)(vb + wave * 1024 + lane * 16) = vr;
}
__device__ __forceinline__ void wave_tile_load(const bf16_t* kt, const bf16_t* vt, LAS unsigned char* kb, LAS unsigned char* vb, int lane) {
    LDS_WAIT();
    { u32x4 kr[8];
#pragma unroll
      for (int c = 0; c < 8; ++c) kr[c] = *(const u32x4*)((const unsigned char*)kt + lane * 128 + c * 16);
#pragma unroll
      for (int c = 0; c < 8; ++c) *(LAS u32x4*)(kb + c * 1024 + lane * 16) = kr[c]; }
    __builtin_amdgcn_sched_barrier(0);
    { u32x4 vr[8];
#pragma unroll
      for (int c = 0; c < 8; ++c) vr[c] = *(const u32x4*)((const unsigned char*)vt + (16 * (c & 3) + (lane >> 2)) * 128 + (c >> 2) * 64 + (lane & 3) * 16);
#pragma unroll
      for (int c = 0; c < 8; ++c) *(LAS u32x4*)(vb + c * 1024 + lane * 16) = vr[c]; }
    LDS_WAIT();
}
__device__ __forceinline__ void wave_tile_issue(const bf16_t* kt, const bf16_t* vt, int lane, u32x4 (&kr)[8], u32x4 (&vr)[8]) {
#pragma unroll
    for (int c = 0; c < 8; ++c) kr[c] = *(const u32x4*)((const unsigned char*)kt + lane * 128 + c * 16);
#pragma unroll
    for (int c = 0; c < 8; ++c) vr[c] = *(const u32x4*)((const unsigned char*)vt + (16 * (c & 3) + (lane >> 2)) * 128 + (c >> 2) * 64 + (lane & 3) * 16);
}
__device__ __forceinline__ void wave_tile_commit(const u32x4 (&kr)[8], const u32x4 (&vr)[8], LAS unsigned char* kb, LAS unsigned char* vb, int lane) {
    LDS_WAIT();
#pragma unroll
    for (int c = 0; c < 8; ++c) *(LAS u32x4*)(kb + c * 1024 + lane * 16) = kr[c];
#pragma unroll
    for (int c = 0; c < 8; ++c) *(LAS u32x4*)(vb + c * 1024 + lane * 16) = vr[c];
    LDS_WAIT();
}
__device__ __forceinline__ void imp_tile(const f32x16& p0, const f32x16& p1, int hi, float& carry, float (&val)[8]) {
    float P4[8], X[8];
#pragma unroll
    for (int gi = 0; gi < 8; ++gi) { const int k = (gi & 3) * 4;
        const float a0 = (gi < 4) ? p0[k] : p1[k], a1 = (gi < 4) ? p0[k + 1] : p1[k + 1], a2 = (gi < 4) ? p0[k + 2] : p1[k + 2], a3 = (gi < 4) ? p0[k + 3] : p1[k + 3];
        P4[gi] = (a0 + a1) + (a2 + a3); X[gi] = __shfl_xor(a3, 32); }
#pragma unroll
    for (int gi = 0; gi < 8; ++gi) val[gi] = P4[gi] + (hi ? X[gi] : (gi == 0 ? carry : X[gi > 0 ? gi - 1 : 0]));
    carry = X[7];
}
__device__ __forceinline__ unsigned topk_select(const LAS float* imp, int cur, int sub) {
    unsigned mask = 0u;
    if (cur <= 15) { if (sub == 0) mask = (2u << cur) - 1u; return mask; }
    unsigned key[32];
    { const LAS float* base = imp + 32 * sub; const int lo = 1 - 32 * sub, hi_ = cur - 2 - 32 * sub;
#pragma unroll
      for (int k = 0; k < 8; ++k) { const f32x4 q = *(const LAS f32x4*)(base + 4 * k);
#pragma unroll
          for (int e = 0; e < 4; ++e) { const int i = 4 * k + e; const unsigned kb = ((__float_as_uint(q[e]) << 1) & 0xffffff80u) | (unsigned)(127 - (32 * sub + i));
              key[i] = (i >= lo && i <= hi_) ? kb : 0u; } } }
    unsigned prev = 0xffffffffu;
    for (int it = 0; it < 13; ++it) {
        const unsigned c = prev - 1u; unsigned g = c - key[0];
#pragma unroll
        for (int i = 1; i < 32; ++i) { const unsigned d = c - key[i]; g = d < g ? d : g; }
#pragma unroll
        for (int off = 1; off <= 2; off <<= 1) { const unsigned og = (unsigned)__shfl_xor((int)g, off); g = og < g ? og : g; }
        prev = c - g;
    }
#pragma unroll
    for (int i = 31; i >= 0; --i) mask = (mask << 1) | ((key[i] >= prev) ? 1u : 0u);
    if (sub == 0) mask |= 1u;
    if (((cur - 1) >> 5) == sub) mask |= 1u << ((cur - 1) & 31);
    if ((cur >> 5) == sub) mask |= 1u << (cur & 31);
    return mask;
}
__device__ __forceinline__ unsigned sel_word(const unsigned (&w)[4], int j) { const int k = j >> 5; return (k == 0) ? w[0] : (k == 1) ? w[1] : (k == 2) ? w[2] : w[3]; }

constexpr float ATT_THR = 8.f;
__device__ __forceinline__ void pv_tile_m(const LAS unsigned char* vb, const f32x16& p0, const f32x16& p1, f32x16& o0, f32x16& o1, int lane, int hi, unsigned enm) {
    const LAS unsigned char* vp = vb + ((lane >> 4) & 1) * 32 + (lane & 3) * 8 + (4 * hi + ((lane & 15) >> 2)) * 64;
#pragma unroll
    for (int kk = 0; kk < 4; ++kk) {
        u32x4 w = __builtin_bit_cast(u32x4, (kk < 2) ? pack8(p0, 8 * kk) : pack8(p1, 8 * (kk - 2)));
        w.x &= enm; w.y &= enm; w.z &= enm; w.w &= enm;
        const bf16x8 pf = __builtin_bit_cast(bf16x8, w);
        const bf16x8 v0 = cat8(tr16(vp + kk * 1024), tr16(vp + kk * 1024 + 512));
        const bf16x8 v1 = cat8(tr16(vp + 4096 + kk * 1024), tr16(vp + 4096 + kk * 1024 + 512));
        o0 = MFMA32(v0, pf, o0); o1 = MFMA32(v1, pf, o1);
    }
}
template <bool EMASK, bool DO_PV>
__device__ __forceinline__ void att_step(const LAS unsigned char* kb, const LAS unsigned char* vb, const bf16x8 (&qr)[4], float& m, float& l, f32x16& nm, f32x16& o0, f32x16& o1,
                                         f32x16& a, f32x16& b, int key0, int klo, int khi, bool en, int lane, int r32, int hi) {
    const LAS unsigned char* kp = kb + hi * 1024 + r32 * 16;
    a = nm; b = nm;
#pragma unroll
    for (int d0 = 0; d0 < 4; ++d0) {
        const bf16x8 k0 = *(const LAS bf16x8*)(kp + d0 * 2048), k1 = *(const LAS bf16x8*)(kp + d0 * 2048 + 512);
        a = MFMA32(k0, qr[d0], a); b = MFMA32(k1, qr[d0], b);
    }
    if (EMASK) mask_tile(a, b, key0, klo, khi, true, hi);
    float mx = tile_max(a, b); mx = en ? mx : NEG_INF;
    const bool unset = m < -1e29f;
    const bool need = unset ? (mx > NEG_INF) : (mx > ATT_THR);
    if (__any(need)) {
        const float d = unset ? (need ? mx : 0.f) : fmaxf(mx, 0.f);
        const float al = unset ? 1.f : fast_exp2(-d);
        m = unset ? (need ? mx : m) : m + d;
        l *= al; if (DO_PV) { o0 = o0 * al; o1 = o1 * al; }
        nm = nm - d; a = a - d; b = b - d;
    }
    float sum = 0.f;
#pragma unroll
    for (int r = 0; r < 16; ++r) { a[r] = fast_exp2(a[r]); b[r] = fast_exp2(b[r]); sum += a[r] + b[r]; }
    l += en ? sum : 0.f;
    if (DO_PV) pv_tile_m(vb, a, b, o0, o1, lane, hi, en ? 0xffffffffu : 0u);
}

typedef __bf16 bf16x2_t __attribute__((ext_vector_type(2)));
__device__ __forceinline__ float bfsum2(unsigned w, float c) { return __builtin_amdgcn_fdot2_f32_bf16(__builtin_bit_cast(bf16x2_t, w), __builtin_bit_cast(bf16x2_t, 0x3f803f80u), c, false); }
template <bool EMASK, bool FIXED, bool ENPERM = false>
__device__ __forceinline__ void att_qk_sm(const LAS unsigned char* kb, const bf16x8 (&qr)[4], float& m, float& l, f32x16& nm, f32x16& o0, f32x16& o1,
                                          u32x4 (&pw)[4], int key0, int klo, int khi, bool en, int r32, int hi, const LAS unsigned char* vb, int lane, bf16x8 (&v0)[4], bf16x8 (&v1)[4]) {
    const LAS unsigned char* kp = kb + hi * 1024 + r32 * 16;
    f32x16 a, b;
    if (FIXED) { a = (f32x16)F16Z; b = (f32x16)F16Z; } else { a = nm; b = nm; }
    bf16x8 kf[8];
#pragma unroll
    for (int d0 = 0; d0 < 4; ++d0) { kf[2 * d0] = *(const LAS bf16x8*)(kp + d0 * 2048); kf[2 * d0 + 1] = *(const LAS bf16x8*)(kp + d0 * 2048 + 512); }
    if (FIXED) { const LAS unsigned char* vp = vb + ((lane >> 4) & 1) * 32 + (lane & 3) * 8 + (4 * hi + ((lane & 15) >> 2)) * 64;
#pragma unroll
      for (int kk = 0; kk < 4; ++kk) { v0[kk] = cat8(tr16(vp + kk * 1024), tr16(vp + kk * 1024 + 512)); v1[kk] = cat8(tr16(vp + 4096 + kk * 1024), tr16(vp + 4096 + kk * 1024 + 512)); } }
    __builtin_amdgcn_s_setprio(1);
#pragma unroll
    for (int d0 = 0; d0 < 4; ++d0) { a = MFMA32(kf[2 * d0], qr[d0], a); b = MFMA32(kf[2 * d0 + 1], qr[d0], b); }
    __builtin_amdgcn_s_setprio(0);
    if (EMASK) mask_tile(a, b, key0, klo, khi, true, hi);
    if (!FIXED) {
        float mx = tile_max(a, b); mx = en ? mx : NEG_INF;
        const bool unset = m < -1e29f;
        const bool need = unset ? (mx > NEG_INF) : (mx > ATT_THR);
        if (__any(need)) {
            const float d = unset ? (need ? mx : 0.f) : fmaxf(mx, 0.f);
            const float al = unset ? 1.f : fast_exp2(-d);
            m = unset ? (need ? mx : m) : m + d;
            l *= al; o0 = o0 * al; o1 = o1 * al;
            nm = nm - d; a = a - d; b = b - d;
        }
    }
#pragma unroll
    for (int r = 0; r < 16; ++r) { a[r] = fast_exp2(a[r]); b[r] = fast_exp2(b[r]); }
    if (FIXED && ENPERM) { unsigned enm_ = en ? 0xffffffffu : 0u; asm volatile("" : "+v"(enm_));
        const unsigned sel = 0x0c0c0c0cu - (enm_ & 0x0506090au);
#pragma unroll
        for (int kk = 0; kk < 4; ++kk)
#pragma unroll
            for (int p = 0; p < 4; ++p) { const int e = 8 * (kk & 1) + 2 * p; const float x0 = (kk < 2) ? a[e] : b[e], x1 = (kk < 2) ? a[e + 1] : b[e + 1];
                pw[kk][p] = __builtin_amdgcn_perm(__float_as_uint(x1), __float_as_uint(x0), sel); }
        return; }
    const unsigned enm = en ? 0xffffffffu : 0u; float sum = 0.f;
#pragma unroll
    for (int kk = 0; kk < 4; ++kk) { u32x4 w = __builtin_bit_cast(u32x4, (kk < 2) ? pack8(a, 8 * kk) : pack8(b, 8 * (kk - 2)));
        w.x &= enm; w.y &= enm; w.z &= enm; w.w &= enm; pw[kk] = w;
        if (!FIXED) { sum = bfsum2(w.x, sum); sum = bfsum2(w.y, sum); sum = bfsum2(w.z, sum); sum = bfsum2(w.w, sum); } }
    if (!FIXED) l += sum;
}
template <bool LSUM>
__device__ __forceinline__ void pv_packed(const LAS unsigned char* vb, int lane, int hi, bf16x8 (&v0)[4], bf16x8 (&v1)[4], const u32x4 (&pw)[4], f32x16& o0, f32x16& o1, f32x4& lacc, const bf16x8& onesA) {
    if (!LSUM) { const LAS unsigned char* vp = vb + ((lane >> 4) & 1) * 32 + (lane & 3) * 8 + (4 * hi + ((lane & 15) >> 2)) * 64;
#pragma unroll
      for (int kk = 0; kk < 4; ++kk) { v0[kk] = cat8(tr16(vp + kk * 1024), tr16(vp + kk * 1024 + 512)); v1[kk] = cat8(tr16(vp + 4096 + kk * 1024), tr16(vp + 4096 + kk * 1024 + 512)); } }
    __builtin_amdgcn_s_setprio(1);
#pragma unroll
    for (int kk = 0; kk < 4; ++kk) { const bf16x8 pf = __builtin_bit_cast(bf16x8, pw[kk]); o0 = MFMA32(v0[kk], pf, o0); o1 = MFMA32(v1[kk], pf, o1);
        if (LSUM) lacc = __builtin_amdgcn_mfma_f32_16x16x32_bf16(onesA, pf, lacc, 0, 0, 0); }
    __builtin_amdgcn_s_setprio(0);
}

constexpr int AT_KB = 0, AT_VB = 32768, AT_IMP = 65536, AT_SEL = 132096;
constexpr int DC_ML = 132096, DC_IMP = 140288, DC_SEL = 141312, DC_OC = 141824;

template <bool FIXED> __device__ __forceinline__ void attn_prompt_unit(const Params& P, const Ctx& C, int bg, int qb) {
    unsigned char* ws = P.ws; LAUNDER_GPTR(ws);
    int lane_ = fresh_lane();
    const int lane = lane_, wave = C.wave, r32 = lane & 31, hi = lane >> 5;
    const int b = bg >> 2, g = bg & 3, qi = r32 & 15, hsel = r32 >> 4, hq = 2 * g + hsel;
    const int t = 128 * qb + 16 * wave + qi;
    const size_t row = (size_t)b * SEQ + t;
    bf16x8 qr[4];
    { const bf16_t* qp = (const bf16_t*)(ws + WS_Q) + row * 512 + hq * 64 + hi * 8;
#pragma unroll
      for (int d0 = 0; d0 < 4; ++d0) qr[d0] = *(const bf16x8*)(qp + d0 * 16); }
    LAS unsigned char* KB = C.lds + AT_KB; LAS unsigned char* VB = C.lds + AT_VB;
    LAS float* IMP = (LAS float*)(C.lds + AT_IMP) + wave * 2048; LAS unsigned* SELM = (LAS unsigned*)(C.lds + AT_SEL) + wave * 64;
    const float* gts = (const float*)(ws + WS_GATES) + row * 24 + hq * 3;
    const float g0 = gts[0], g1 = gts[1], g2 = gts[2];
    f32x16 oa0, oa1, s0, s1;
    u32x4 kr, vr, kr2, vr2;
    const int t0 = 128 * qb + 16 * wave;
    f32x16 nm;
    {
        const int ntc = (qb >> 3) + 1, cmax = (t >= 31) ? ((t - 31) >> 4) : -1, cmin_w = (t0 >= 31) ? ((t0 - 31) >> 4) : -1;
        const bf16_t* kcb = (const bf16_t*)(ws + WS_KCC) + (size_t)bg * 512 * 64; const bf16_t* vcb = (const bf16_t*)(ws + WS_VCC) + (size_t)bg * 512 * 64;
        float m_c = -1e30f, l_c = 0.f; nm = (f32x16)F16Z;
        __syncthreads();
        tile_ld(kcb, vcb, wave, lane, kr, vr);
        for (int j = 0; j < ntc; ++j) {
            tile_st(KB + (j & 1) * 8192, VB + (j & 1) * 8192, wave, lane, kr, vr);
            __syncthreads();
            if (j + 1 < ntc) tile_ld(kcb + (size_t)(j + 1) * 4096, vcb + (size_t)(j + 1) * 4096, wave, lane, kr, vr);
            else tile_ld(kcb, vcb, wave, lane, kr, vr);
            if (64 * j + 63 <= cmin_w) att_step<false, false>(KB + (j & 1) * 8192, VB, qr, m_c, l_c, nm, s0, s1, s0, s1, 64 * j, 0, cmax, true, lane, r32, hi);
            else att_step<true, false>(KB + (j & 1) * 8192, VB, qr, m_c, l_c, nm, s0, s1, s0, s1, 64 * j, 0, cmax, true, lane, r32, hi);
        }
        nm = nm - __builtin_amdgcn_logf(fmaxf(half_swap_sum(l_c), 1e-20f));
        f32x16 oc0 = F16Z, oc1 = F16Z; float carry = 0.f;
        __syncthreads();
        for (int j = 0; j < ntc; ++j) {
            tile_st(KB + (j & 1) * 8192, VB + (j & 1) * 8192, wave, lane, kr, vr);
            __syncthreads();
            if (j + 1 < ntc) tile_ld(kcb + (size_t)(j + 1) * 4096, vcb + (size_t)(j + 1) * 4096, wave, lane, kr, vr);
            else { const bf16_t* ks_ = (const bf16_t*)(ws + WS_KS) + (size_t)bg * SEQ * 64; const bf16_t* vs_ = (const bf16_t*)(ws + WS_VS) + (size_t)bg * SEQ * 64;
                   tile_ld(ks_, vs_, wave, lane, kr, vr); tile_ld(ks_ + 4096, vs_ + 4096, wave, lane, kr2, vr2); }
            { const LAS unsigned char* kp = KB + (j & 1) * 8192 + hi * 1024 + r32 * 16; s0 = nm; s1 = nm;
#pragma unroll
              for (int d0 = 0; d0 < 4; ++d0) { const bf16x8 k0 = *(const LAS bf16x8*)(kp + d0 * 2048), k1 = *(const LAS bf16x8*)(kp + d0 * 2048 + 512);
                  s0 = MFMA32(k0, qr[d0], s0); s1 = MFMA32(k1, qr[d0], s1); } }
            if (64 * j + 63 > cmin_w) mask_tile(s0, s1, 64 * j, 0, cmax, true, hi);
#pragma unroll
            for (int r = 0; r < 16; ++r) { s0[r] = fast_exp2(s0[r]); s1[r] = fast_exp2(s1[r]); }
            float val[8]; imp_tile(s0, s1, hi, carry, val);
#pragma unroll
            for (int gi = 0; gi < 8; ++gi) val[gi] += __shfl_xor(val[gi], 16);
            if (hsel == 0) {
#pragma unroll
                for (int gi = 0; gi < 8; ++gi) IMP[qi * 128 + 16 * j + 2 * gi + hi] = val[gi]; }
            pv_tile(VB + (j & 1) * 8192, s0, s1, oc0, oc1, lane, hi);
        }
        LDS_WAIT();
        { const int tq = lane >> 2, sub = lane & 3, cur = (128 * qb + 16 * wave + tq) >> 6;
          const unsigned m = topk_select(IMP + tq * 128, cur, sub);
          SELM[tq * 4 + sub] = m; }
        LDS_WAIT();
#pragma unroll
        for (int r = 0; r < 16; ++r) { IMP[r * 64 + lane] = oc0[r] * g0; IMP[(16 + r) * 64 + lane] = oc1[r] * g0; }
    }
    unsigned selw[4];
#pragma unroll
    for (int k = 0; k < 4; ++k) selw[k] = SELM[qi * 4 + k];
    const unsigned one2 = ((lane & 15) == ((lane >> 4) & 1)) ? 0x3f803f80u : 0u;
    const bf16x8 onesA = __builtin_bit_cast(bf16x8, (u32x4){one2, one2, one2, one2});
    {
        const bf16_t* kb_ = (const bf16_t*)(ws + WS_KS) + (size_t)bg * SEQ * 64; const bf16_t* vb_ = (const bf16_t*)(ws + WS_VS) + (size_t)bg * SEQ * 64;
        const int jl = 2 * qb + 1, cur_w = t0 >> 6;
        float m_s = -1e30f, l_s = 0.f; f32x16 o0 = F16Z, o1 = F16Z; nm = (f32x16)F16Z; f32x4 lacc = {0.f, 0.f, 0.f, 0.f};
        u32x4 pw[4];
        __syncthreads();
        for (int jp = 0; jp <= jl; jp += 2) {
            LAS unsigned char* kcur = KB + ((jp >> 1) & 1) * 16384; LAS unsigned char* vcur = VB + ((jp >> 1) & 1) * 16384;
            tile_st(kcur, vcur, wave, lane, kr, vr); tile_st(kcur + 8192, vcur + 8192, wave, lane, kr2, vr2);
            __syncthreads();
            if (jp + 2 <= jl) { tile_ld(kb_ + (size_t)(jp + 2) * 4096, vb_ + (size_t)(jp + 2) * 4096, wave, lane, kr, vr); tile_ld(kb_ + (size_t)(jp + 3) * 4096, vb_ + (size_t)(jp + 3) * 4096, wave, lane, kr2, vr2); }
            else { const int jw_ = (2 * qb - 8 > 0) ? 2 * qb - 8 : 0; const bf16_t* kw_ = (const bf16_t*)(ws + WS_KW) + (size_t)bg * SEQ * 64; const bf16_t* vw_ = (const bf16_t*)(ws + WS_VW) + (size_t)bg * SEQ * 64;
                   tile_ld(kw_ + (size_t)jw_ * 4096, vw_ + (size_t)jw_ * 4096, wave, lane, kr, vr); tile_ld(kw_ + (size_t)(jw_ + 1) * 4096, vw_ + (size_t)(jw_ + 1) * 4096, wave, lane, kr2, vr2); }
#pragma unroll
            for (int h2 = 0; h2 < 2; ++h2) { const int j = jp + h2;
                const bool en = (sel_word(selw, j) >> (j & 31)) & 1u;
                const bool act = (j < cur_w) ? (bool)__any(en) : (j == cur_w);
                if (act) {
                    bf16x8 v0[4], v1[4];
                    if (j < cur_w) att_qk_sm<false, FIXED, true>(kcur + h2 * 8192, qr, m_s, l_s, nm, o0, o1, pw, 64 * j, 0, t, en, r32, hi, vcur + h2 * 8192, lane, v0, v1);
                    else att_qk_sm<true, FIXED>(kcur + h2 * 8192, qr, m_s, l_s, nm, o0, o1, pw, 64 * j, 0, t, en, r32, hi, vcur + h2 * 8192, lane, v0, v1);
                    pv_packed<FIXED>(vcur + h2 * 8192, lane, hi, v0, v1, pw, o0, o1, lacc, onesA);
                } }
        }
        if (FIXED) { const float l0 = __shfl(lacc[0], qi), l1 = __shfl(lacc[1], qi); l_s = hsel ? l1 : l0; } else l_s = half_swap_sum(l_s);
        const float sc = g1 / fmaxf(l_s, 1e-20f);
#pragma unroll
        for (int r = 0; r < 16; ++r) { IMP[r * 64 + lane] += o0[r] * sc; IMP[(16 + r) * 64 + lane] += o1[r] * sc; }
    }
    {
        const bf16_t* kb_ = (const bf16_t*)(ws + WS_KW) + (size_t)bg * SEQ * 64; const bf16_t* vb_ = (const bf16_t*)(ws + WS_VW) + (size_t)bg * SEQ * 64;
        const int j0 = (2 * qb - 8 > 0) ? 2 * qb - 8 : 0, jl = 2 * qb + 1;
        float m_w = -1e30f, l_w = 0.f; f32x16 o0 = F16Z, o1 = F16Z; nm = (f32x16)F16Z; f32x4 lacc = {0.f, 0.f, 0.f, 0.f};
        u32x4 pw[4];
        __syncthreads();
        for (int jp = j0; jp <= jl; jp += 2) {
            LAS unsigned char* kcur = KB + ((jp >> 1) & 1) * 16384; LAS unsigned char* vcur = VB + ((jp >> 1) & 1) * 16384;
            tile_st(kcur, vcur, wave, lane, kr, vr); tile_st(kcur + 8192, vcur + 8192, wave, lane, kr2, vr2);
            __syncthreads();
            if (jp + 2 <= jl) { tile_ld(kb_ + (size_t)(jp + 2) * 4096, vb_ + (size_t)(jp + 2) * 4096, wave, lane, kr, vr); tile_ld(kb_ + (size_t)(jp + 3) * 4096, vb_ + (size_t)(jp + 3) * 4096, wave, lane, kr2, vr2); }
#pragma unroll
            for (int h2 = 0; h2 < 2; ++h2) { const int j = jp + h2;
                const bool anyv = (64 * j <= t0 + 15) && (64 * j + 63 >= t0 - 511), allv = (64 * j + 63 <= t0) && (64 * j >= t0 + 15 - 511);
                if (anyv) {
                    bf16x8 v0[4], v1[4];
                    if (allv) att_qk_sm<false, FIXED>(kcur + h2 * 8192, qr, m_w, l_w, nm, o0, o1, pw, 64 * j, t - 511, t, true, r32, hi, vcur + h2 * 8192, lane, v0, v1);
                    else att_qk_sm<true, FIXED>(kcur + h2 * 8192, qr, m_w, l_w, nm, o0, o1, pw, 64 * j, t - 511, t, true, r32, hi, vcur + h2 * 8192, lane, v0, v1);
                    pv_packed<FIXED>(vcur + h2 * 8192, lane, hi, v0, v1, pw, o0, o1, lacc, onesA);
                } }
        }
        if (FIXED) { const float l0 = __shfl(lacc[0], qi), l1 = __shfl(lacc[1], qi); l_w = hsel ? l1 : l0; } else l_w = half_swap_sum(l_w);
        const float sc = g2 / fmaxf(l_w, 1e-20f);
#pragma unroll
        for (int r = 0; r < 16; ++r) { oa0[r] = IMP[r * 64 + lane] + o0[r] * sc; oa1[r] = IMP[(16 + r) * 64 + lane] + o1[r] * sc; }
    }
    bf16_t* mo = (bf16_t*)(ws + WS_MIX) + row * 1024 + 512 + hq * 64 + 4 * hi;
#pragma unroll
    for (int rq = 0; rq < 4; ++rq) { u32x2 w;
        w.x = cvt_pk_bf16(oa0[4 * rq], oa0[4 * rq + 1]); w.y = cvt_pk_bf16(oa0[4 * rq + 2], oa0[4 * rq + 3]); *(u32x2*)(mo + 8 * rq) = w;
        w.x = cvt_pk_bf16(oa1[4 * rq], oa1[4 * rq + 1]); w.y = cvt_pk_bf16(oa1[4 * rq + 2], oa1[4 * rq + 3]); *(u32x2*)(mo + 32 + 8 * rq) = w; }
}

__device__ __forceinline__ void wave_k_load(const bf16_t* kt, LAS unsigned char* kb, int lane) {
    LDS_WAIT();
    u32x4 kr[8];
#pragma unroll
    for (int c = 0; c < 8; ++c) kr[c] = *(const u32x4*)((const unsigned char*)kt + lane * 128 + c * 16);
#pragma unroll
    for (int c = 0; c < 8; ++c) *(LAS u32x4*)(kb + c * 1024 + lane * 16) = kr[c];
    LDS_WAIT();
}
__device__ __forceinline__ void wave_v_load(const bf16_t* vt, LAS unsigned char* vb, int lane) {
    LDS_WAIT();
    u32x4 vr[8];
#pragma unroll
    for (int c = 0; c < 8; ++c) vr[c] = *(const u32x4*)((const unsigned char*)vt + (16 * (c & 3) + (lane >> 2)) * 128 + (c >> 2) * 64 + (lane & 3) * 16);
#pragma unroll
    for (int c = 0; c < 8; ++c) *(LAS u32x4*)(vb + c * 1024 + lane * 16) = vr[c];
    LDS_WAIT();
}
struct F32Tile { f32x4 x[16]; };
__device__ __forceinline__ void f32_k_issue(F32Tile& T, const float* kp, int lane) {
    const float* kl = kp + (size_t)(lane >> 4) * 256 + (lane & 15) * 4;
#pragma unroll
    for (int i = 0; i < 16; ++i) T.x[i] = *(const f32x4*)(kl + (size_t)(4 * i) * 256);
}
template <int H> __device__ __forceinline__ void f32_k_commit(const F32Tile& T, LAS unsigned char* kb, int lane, float* kcopy, int skip) {
    const int pc = lane & 15, rl = lane >> 4, c = pc >> 1;
    float* kc = kcopy + (size_t)rl * 256 + pc * 4;
    const unsigned keo = (unsigned)(c * 1024 + (pc & 1) * 8 + ((rl + c) & 7) * 16);
    if (H == 0) LDS_WAIT();
#pragma unroll
    for (int i = 8 * H; i < 8 * H + 8; ++i) { u32x2 w; w.x = cvt_pk_bf16(T.x[i][0], T.x[i][1]); w.y = cvt_pk_bf16(T.x[i][2], T.x[i][3]);
        *(LAS u32x2*)(kb + ((i & 1) ? (keo ^ 64u) : keo) + 128 * (i >> 1)) = w;
        if (kcopy && 4 * i + rl >= skip) *(f32x4*)(kc + (size_t)(4 * i) * 256) = T.x[i]; }
    if (H == 1) LDS_WAIT();
}
struct F32Half { f32x4 x[8]; };
__device__ __forceinline__ void f32_v_issue(F32Half& T, const float* vp, int lane, int h) {
    const float* vl = vp + (size_t)(lane >> 4) * 256 + (lane & 15) * 4;
#pragma unroll
    for (int i = 0; i < 8; ++i) T.x[i] = *(const f32x4*)(vl + (size_t)(4 * (8 * h + i)) * 256);
}
__device__ __forceinline__ void f32_v_commit(const F32Half& T, LAS unsigned char* vb, int lane, float* vcopy, int skip, int h) {
    const int pc = lane & 15, rl = lane >> 4;
    LAS unsigned char* vd = vb + (pc >> 3) * 4096 + rl * 64 + (pc & 7) * 8; float* vc = vcopy + (size_t)rl * 256 + pc * 4;
#pragma unroll
    for (int i = 0; i < 8; ++i) { const int ri = 4 * (8 * h + i); u32x2 w; w.x = cvt_pk_bf16(T.x[i][0], T.x[i][1]); w.y = cvt_pk_bf16(T.x[i][2], T.x[i][3]);
        *(LAS u32x2*)(vd + ri * 64) = w;
        if (vcopy && ri + rl >= skip) *(f32x4*)(vc + (size_t)ri * 256) = T.x[i]; }
}
#define F32_TILE_STEP(kp_, vp_, kc_, vc_, skip_, key0_, klo_, khi_, en_, M_, L_, O0_, O1_) do { \
    F32Half TA_, TB_; \
    { F32Tile TK_; f32_k_issue(TK_, kp_, lane); f32_v_issue(TA_, vp_, lane, 0);     \
      f32_k_commit<0>(TK_, KB, lane, kc_, skip_); f32_v_issue(TB_, vp_, lane, 1); f32_k_commit<1>(TK_, KB, lane, kc_, skip_); } \
    qk_tile_sw(KB, qr, s0, s1, r32, hi); mask_tile(s0, s1, key0_, klo_, khi_, en_, hi); softmax_step(s0, s1, M_, L_, O0_, O1_); \
    LDS_WAIT(); f32_v_commit(TA_, VB, lane, vc_, skip_, 0); f32_v_commit(TB_, VB, lane, vc_, skip_, 1); LDS_WAIT(); pv_tile(VB, s0, s1, O0_, O1_, lane, hi); } while (0)

__device__ __forceinline__ void attn_decode_unit(const Params& P, const Ctx& C, int sg) {
    unsigned char* ws = P.ws; LAUNDER_GPTR(ws);
    const float* in6 = P.in[6]; const float* in7 = P.in[7]; float* outp = P.out;
    LAUNDER_GPTR(in6); LAUNDER_GPTR(in7); LAUNDER_GPTR(outp);
    int lane_ = fresh_lane();
    const int lane = lane_, wave = C.wave, r32 = lane & 31, hi = lane >> 5, r8 = r32 & 7;
    const int seq = sg >> 2, g = sg & 3, qi = r8 & 3, hsel = r8 >> 2, hq = 2 * g + hsel;
    const int t = PAST + qi;
    const size_t row = (size_t)NPR + seq * 4 + qi;
    bf16x8 qr[4];
    { const bf16_t* qp = (const bf16_t*)(ws + WS_Q) + row * 512 + hq * 64 + hi * 8;
#pragma unroll
      for (int d0 = 0; d0 < 4; ++d0) qr[d0] = *(const bf16x8*)(qp + d0 * 16); }
    LAS unsigned char* KB = C.lds + wave * 16384; LAS unsigned char* VB = KB + 8192;
    LAS float* ML = (LAS float*)(C.lds + DC_ML); LAS float* DIMP = (LAS float*)(C.lds + DC_IMP); LAS unsigned* DSEL = (LAS unsigned*)(C.lds + DC_SEL);
    LAS float* DOC = (LAS float*)(C.lds + DC_OC);
    f32x16 s0, s1;
    float m_w = -1e30f, l_w = 0.f; f32x16 ow0 = F16Z, ow1 = F16Z;
    __syncthreads();
    if (wave == 0) {
        const bf16_t* kcb = (const bf16_t*)(ws + WS_KCC) + ((size_t)4096 + sg * 128) * 64; const bf16_t* vcb = (const bf16_t*)(ws + WS_VCC) + ((size_t)4096 + sg * 128) * 64;
        const int cmax = (t - 31) >> 4;
        f32x16 oc0 = F16Z, oc1 = F16Z; float carry = 0.f; float val0[8], val1[8];
        u32x4 k0r[8], v0r[8], k1r[8], v1r[8];
        wave_tile_issue(kcb, vcb, lane, k0r, v0r); wave_tile_issue(kcb + 4096, vcb + 4096, lane, k1r, v1r);
        wave_tile_commit(k0r, v0r, KB, VB, lane); qk_tile(KB, qr, s0, s1, r32, hi); mask_tile(s0, s1, 0, 0, cmax, true, hi);
        const float m0 = tile_max(s0, s1); float l0 = 0.f;
#pragma unroll
        for (int r = 0; r < 16; ++r) { s0[r] = fast_exp2(s0[r] - m0); s1[r] = fast_exp2(s1[r] - m0); l0 += s0[r] + s1[r]; }
        imp_tile(s0, s1, hi, carry, val0);
        pv_tile(VB, s0, s1, oc0, oc1, lane, hi);
        wave_tile_commit(k1r, v1r, KB, VB, lane); qk_tile(KB, qr, s0, s1, r32, hi); mask_tile(s0, s1, 64, 0, cmax, true, hi);
        const float m1 = fmaxf(m0, tile_max(s0, s1)); const float a = fast_exp2(m0 - m1); float l1 = 0.f;
#pragma unroll
        for (int r = 0; r < 16; ++r) { s0[r] = fast_exp2(s0[r] - m1); s1[r] = fast_exp2(s1[r] - m1); l1 += s0[r] + s1[r]; }
        carry *= a; oc0 = oc0 * a; oc1 = oc1 * a;
        imp_tile(s0, s1, hi, carry, val1);
        pv_tile(VB, s0, s1, oc0, oc1, lane, hi);
        const float inv = 1.0f / fmaxf(half_swap_sum(l0 * a + l1), 1e-20f); const float inva = inv * a;
#pragma unroll
        for (int gi = 0; gi < 8; ++gi) { float w0 = val0[gi] * inva, w1 = val1[gi] * inv;
            w0 += __shfl_xor(w0, 4); w1 += __shfl_xor(w1, 4);
            if (r32 < 4) { DIMP[r32 * 64 + 2 * gi + hi] = w0; DIMP[r32 * 64 + 16 + 2 * gi + hi] = w1; } }
        if (lane < 4) DIMP[lane * 64 + 32] = 0.f;
#pragma unroll
        for (int r = 0; r < 16; ++r) { DOC[r * 64 + lane] = oc0[r] * inv; DOC[(16 + r) * 64 + lane] = oc1[r] * inv; }
        LDS_WAIT();
        { const int tq = (lane >> 2) & 3, sub = lane & 3, cur = (PAST + tq) >> 6;
          const unsigned m = topk_select(DIMP + tq * 64, cur, sub);
          if (lane < 16 && sub < 2) DSEL[tq * 2 + sub] = m; }
        LDS_WAIT();
    }
    const float* sk = in6 + (size_t)seq * (512 * 256) + g * 64; const float* sv = in7 + (size_t)seq * (512 * 256) + g * 64;
    float* ck = outp + O_SKW + (size_t)seq * (512 * 256) + g * 64; float* cv = outp + O_SVW + (size_t)seq * (512 * 256) + g * 64;
    if (wave != 0) { const int j = wave;
        F32_TILE_STEP(sk + (size_t)j * 64 * 256, sv + (size_t)j * 64 * 256, ck + ((ptrdiff_t)j * 64 - 4) * 256, cv + ((ptrdiff_t)j * 64 - 4) * 256, 0, 64 * j, qi + 1, 512 + qi, true, m_w, l_w, ow0, ow1); }
    __syncthreads();
    float m_s = -1e30f, l_s = 0.f; f32x16 os0 = F16Z, os1 = F16Z;
    if (wave == 0) {
        F32_TILE_STEP(sk, sv, ck - 4 * 256, cv - 4 * 256, 4, 0, qi + 1, 512 + qi, true, m_w, l_w, ow0, ow1);
        wave_tile_load((const bf16_t*)(ws + WS_CWK) + (size_t)sg * 4096, (const bf16_t*)(ws + WS_CWV) + (size_t)sg * 4096, KB, VB, lane);
        qk_tile(KB, qr, s0, s1, r32, hi); mask_tile(s0, s1, 512, qi + 1, 512 + qi, true, hi);
        softmax_step(s0, s1, m_w, l_w, ow0, ow1); pv_tile(VB, s0, s1, ow0, ow1, lane, hi);
    }
    if (wave != 0) {
      unsigned selw[4]; selw[0] = DSEL[qi * 2]; selw[1] = DSEL[qi * 2 + 1]; selw[2] = 0u; selw[3] = 0u;
      const int* in8 = (const int*)P.in[8]; LAUNDER_GPTR(in8); const int* pt = in8 + seq * 16;
      for (int j = wave - 1; j <= 32; j += 7) {
          const bool en = ((sel_word(selw, j) >> (j & 31)) & 1u) && (64 * j <= t);
          if (__any(en)) {
              if (j < 32) { const size_t po = (size_t)pt[j >> 1] * (128 * 256) + (size_t)(j & 1) * 64 * 256 + g * 64;
                  const float* in4 = P.in[4]; const float* in5 = P.in[5]; LAUNDER_GPTR(in4); LAUNDER_GPTR(in5);
                  F32_TILE_STEP(in4 + po, in5 + po, (float*)nullptr, (float*)nullptr, 0, 64 * j, 0, t, en, m_s, l_s, os0, os1); }
              else { wave_tile_load((const bf16_t*)(ws + WS_CKS) + (size_t)sg * 4096, (const bf16_t*)(ws + WS_CVS) + (size_t)sg * 4096, KB, VB, lane);
                  qk_tile(KB, qr, s0, s1, r32, hi); mask_tile(s0, s1, 64 * j, 0, t, en, hi);
                  softmax_step(s0, s1, m_s, l_s, os0, os1); pv_tile(VB, s0, s1, os0, os1, lane, hi); } } } }
    LDS_WAIT();
    { LAS float* ml = ML + wave * 256 + lane * 4; ml[0] = m_s; ml[1] = l_s; ml[2] = m_w; ml[3] = l_w;
      LAS float* ob = (LAS float*)KB;
#pragma unroll
      for (int r = 0; r < 16; ++r) { ob[r * 64 + lane] = os0[r]; ob[(16 + r) * 64 + lane] = os1[r]; ob[(32 + r) * 64 + lane] = ow0[r]; ob[(48 + r) * 64 + lane] = ow1[r]; } }
    __syncthreads();
    if (wave == 0) {
        float Ms = -1e30f, Mw = -1e30f;
#pragma unroll
        for (int w = 0; w < 8; ++w) { Ms = fmaxf(Ms, ML[w * 256 + lane * 4]); Mw = fmaxf(Mw, ML[w * 256 + lane * 4 + 2]); }
        float Ls = 0.f, Lw = 0.f;
#pragma unroll
        for (int w = 0; w < 8; ++w) { const LAS float* ml = ML + w * 256 + lane * 4; Ls += ml[1] * fast_exp2(ml[0] - Ms); Lw += ml[3] * fast_exp2(ml[2] - Mw); }
        const float* gts = (const float*)(ws + WS_GATES) + row * 24 + hq * 3;
        const float g0 = gts[0], scs = gts[1] / fmaxf(half_swap_sum(Ls), 1e-20f), scw = gts[2] / fmaxf(half_swap_sum(Lw), 1e-20f);
        f32x16 oa0, oa1;
#pragma unroll
        for (int r = 0; r < 16; ++r) { oa0[r] = DOC[r * 64 + lane] * g0; oa1[r] = DOC[(16 + r) * 64 + lane] * g0; }
        for (int w = 0; w < 8; ++w) { const LAS float* ml = ML + w * 256 + lane * 4; const float fs = fast_exp2(ml[0] - Ms) * scs, fw = fast_exp2(ml[2] - Mw) * scw;
            const LAS float* ob = (const LAS float*)(C.lds + w * 16384);
#pragma unroll
            for (int r = 0; r < 16; ++r) { oa0[r] += ob[r * 64 + lane] * fs + ob[(32 + r) * 64 + lane] * fw; oa1[r] += ob[(16 + r) * 64 + lane] * fs + ob[(48 + r) * 64 + lane] * fw; } }
        if (r32 < 8) {
            bf16_t* mo = (bf16_t*)(ws + WS_MIX) + row * 1024 + 512 + hq * 64 + 4 * hi;
#pragma unroll
            for (int rq = 0; rq < 4; ++rq) { u32x2 w;
                w.x = cvt_pk_bf16(oa0[4 * rq], oa0[4 * rq + 1]); w.y = cvt_pk_bf16(oa0[4 * rq + 2], oa0[4 * rq + 3]); *(u32x2*)(mo + 8 * rq) = w;
                w.x = cvt_pk_bf16(oa1[4 * rq], oa1[4 * rq + 1]); w.y = cvt_pk_bf16(oa1[4 * rq + 2], oa1[4 * rq + 3]); *(u32x2*)(mo + 32 + 8 * rq) = w; }
        }
    }
}

constexpr int CW_QUEUE = 16384;
__device__ __forceinline__ void phase_attention(const Params& P, const Ctx& C, int parts, int qset) {
    unsigned* qc = (unsigned*)(P.ws + WS_CTL) + CW_QUEUE + qset * 512;
    volatile LAS unsigned* slot = (volatile LAS unsigned*)(C.lds + MISC_OFF) + 16;
    const bool fixed_ok = ((const float*)(P.ws + WS_PEB))[768] < 100.f;
    const int x0 = (int)(xb_xcc_id() & 7u);
    for (int i = 0; i < 8; ++i) { const int x = (x0 + i) & 7;
        for (;;) {
            __syncthreads();
            if (C.wave == 0 && fresh_lane() == 0) *slot = __hip_atomic_fetch_add(qc + 64 * x, 1u, __ATOMIC_RELAXED, __HIP_MEMORY_SCOPE_AGENT);
            __syncthreads();
            const unsigned u = *slot;
            if (u >= 128u) break;
            const int us = __builtin_amdgcn_readfirstlane((int)u);
            int pq = -1, dq = -1;
            if (us < 96) { const int k = us / 3, r = us - 3 * k; if (r == 0) pq = 63 - k; else dq = 2 * k + r - 1; } else pq = 127 - us;
            if (pq >= 0) { if (parts & 1) { if (fixed_ok) attn_prompt_unit<true>(P, C, x, pq); else attn_prompt_unit<false>(P, C, x, pq); } }
            else { if (parts & 2) attn_decode_unit(P, C, x * 64 + dq); }
        }
    }
}
constexpr int N_PHASES = 10;

__global__ void __launch_bounds__(NWAVES * 64, 2) fwd_kernel(Params P) {
    extern __shared__ __attribute__((aligned(16))) unsigned char lds_raw[];
    Ctx C;
    C.lds = (LAS unsigned char*)lds_raw;
    C.wave = __builtin_amdgcn_readfirstlane(threadIdx.x >> 6);
    C.nblk = gridDim.x; C.blk = blockIdx.x;
    volatile LAS unsigned* MISC = (volatile LAS unsigned*)(C.lds + MISC_OFF);
    for (int u = threadIdx.x; u < (LDS_BYTES - LDSCTL_OFF) / 4; u += NWAVES * 64) ((LAS unsigned*)(C.lds + LDSCTL_OFF))[u] = 0u;
    __syncthreads();
    unsigned* ctl = (unsigned*)(P.ws + WS_CTL);
    XcdBarrier bar = xcd_barrier_post(ctl + CW_BAR + P.li * XCD_BAR_WORDS, MISC + 8);
    const int lo = P.ph_lo, hi = P.ph_hi;
#ifndef PHASE_MASK
#define PHASE_MASK 0x3ff
#endif
#define IN(k) (((PHASE_MASK >> (k)) & 1) && lo <= (k) && (k) < hi)
#define SEAM(k) do { if (IN(k) && IN((k) + 1)) xcd_barrier(bar, C.wave); } while (0)
    const int vblk = (C.nblk % 8 == 0) ? (C.blk % 8) * (C.nblk / 8) + C.blk / 8 : C.blk; (void)vblk;

#define PH0 { phase_prologue(P, C, P.pad & 31); }
#define PH1 { phase_modulate<0>(P, C); }
#define PH2 { const int cgrp = (C.blk >> 3) & 1;     \
        _Pragma("unroll 1") for (int s_ = 0; s_ < 2; ++s_) { \
        if ((s_ == 0) == (cgrp == 0)) cache_convert(P, C); \
        if (s_ == 0) { pg8::Gemm g{(const bf16_t*)(ws + WS_H), (const bf16_t*)(ws + WS_WTIN), NR, INCP, DM, DM, DM}; pg8::StaticOrder S; S.init(NR, INCP, C.nblk, C.blk); \
          pg8::EpiProj E{&P}; pg8::gemm_phase<pg8::EpiProj, pg8::StaticOrder, true, true>(C.lds, g, S, E, C.wave); } } }
#define PH3 { { pg8::Gemm g{nullptr, nullptr, NCROWS, 256, 2048, 1024, 2048}; \
          pg8::CmpOrder<0> S{(const char*)(ws + WS_AK), (const char*)(ws + WS_AV), (const char*)(ws + WS_WTC1K), (const char*)(ws + WS_WTC1V), C.nblk, C.blk}; \
          pg8::EpiCmp E{(bf16_t*)(ws + WS_HIDK), (bf16_t*)(ws + WS_HIDV), (const float*)(ws + WS_PEB)}; pg8::gemm_phase<pg8::EpiCmp, pg8::CmpOrder<0>, true, true>(C.lds, g, S, E, C.wave); VM_WAIT(); __syncthreads(); \
          { pg8::Unit u_; for (int i_ = 0; S.next(i_, u_); ++i_) cmp2_tile(P, C, u_.kind, u_.pm); } }     \
        const bool split = C.nblk >= 64; \
        if (!split || C.blk < 32) { pg8::Gemm g{nullptr, nullptr, NCROWS, 256, 2048, 1024, 2048}; \
          pg8::CmpOrder<1> S{(const char*)(ws + WS_AK), (const char*)(ws + WS_AV), (const char*)(ws + WS_WTC1K), (const char*)(ws + WS_WTC1V), C.nblk, C.blk}; \
          pg8::EpiCmp E{(bf16_t*)(ws + WS_HIDK), (bf16_t*)(ws + WS_HIDV), (const float*)(ws + WS_PEB)}; pg8::gemm_phase<pg8::EpiCmp, pg8::CmpOrder<1>, true, true>(C.lds, g, S, E, C.wave); VM_WAIT(); __syncthreads(); \
          { pg8::Unit u_; for (int i_ = 0; S.next(i_, u_); ++i_) cmp2_tile(P, C, u_.kind, u_.pm); } } \
        if (!split) phase_chunk_mlp(P, C, C.blk, C.nblk); else if (C.blk >= 32) phase_chunk_mlp(P, C, C.blk - 32, C.nblk - 32); }
#define PH4 { }
#define PH5 { phase_attention(P, C, (P.pad >> 8) & 3, P.li); }
#define PH6 { pg8::Gemm g{(const bf16_t*)(ws + WS_MIX), (const bf16_t*)(ws + WS_WTOUT), NPR, DM, DM, DM, DM}; pg8::StaticOrder S; S.init(NPR, DM, C.nblk, C.blk); \
        pg8::EpiResid<0> E{&P}; pg8::gemm_phase<pg8::EpiResid<0>, pg8::StaticOrder, true, true>(C.lds, g, S, E, C.wave); sample_rows_gemm<0>(P, C); }
#define PH7 { phase_modulate<1>(P, C); }
#define PH8 { pg8::Gemm g{(const bf16_t*)(ws + WS_H), (const bf16_t*)(ws + WS_WTF1), NR, 2 * DFF, DM, DM, DM}; pg8::StaticOrder S; S.init(NR, 2 * DFF, C.nblk, C.blk); \
        pg8::EpiSwiglu E{&P}; pg8::gemm_phase<pg8::EpiSwiglu, pg8::StaticOrder, true, true>(C.lds, g, S, E, C.wave); }
#define PH9 { pg8::Gemm g{(const bf16_t*)(ws + WS_F), (const bf16_t*)(ws + WS_WTF2), NPR, DM, DFF, DFF, DFF}; pg8::StaticOrder S; S.init(NPR, DM, C.nblk, C.blk); \
        pg8::EpiResid<1> E{&P}; pg8::gemm_phase<pg8::EpiResid<1>, pg8::StaticOrder, true, true>(C.lds, g, S, E, C.wave); sample_rows_gemm<1>(P, C); }
#define RUN(k, BODY) do { if (IN(k)) { unsigned char* ws = P.ws; LAUNDER_GPTR(ws); BODY } } while (0)
    RUN(0, PH0); SEAM(0);
    RUN(1, PH1); SEAM(1);
    RUN(2, PH2); SEAM(2);
    RUN(3, PH3); SEAM(3);
    RUN(4, PH4);
    RUN(5, PH5); SEAM(5);
    RUN(6, PH6); SEAM(6);
    RUN(7, PH7); SEAM(7);
    RUN(8, PH8); SEAM(8);
    RUN(9, PH9);
#undef IN
#undef SEAM
}

extern "C" void kernel_launch(void* const* d_in, const int* in_sizes, int n_in, void* d_out, int out_size, void* d_ws, size_t ws_size, hipStream_t stream) {
    static int grid = 0;
    if (grid == 0) {
        if (n_in != 32 || out_size != (int)O_TOTAL || ws_size < WS_END) { fprintf(stderr, "kernel_launch: unexpected shapes (n_in %d, out %d, ws %zu)\n", n_in, out_size, ws_size); grid = -1; return; }
        int dev = 0, cus = 0, per_cu = 0;
        if (hipGetDevice(&dev) != hipSuccess || hipDeviceGetAttribute(&cus, hipDeviceAttributeMultiprocessorCount, dev) != hipSuccess) { grid = -1; return; }
        if (hipFuncSetAttribute((const void*)fwd_kernel, hipFuncAttributeMaxDynamicSharedMemorySize, LDS_BYTES) != hipSuccess) { fprintf(stderr, "kernel_launch: hipFuncSetAttribute failed\n"); grid = -1; return; }
        if (hipOccupancyMaxActiveBlocksPerMultiprocessor(&per_cu, (const void*)fwd_kernel, NWAVES * 64, LDS_BYTES) != hipSuccess || per_cu < 1) { fprintf(stderr, "kernel_launch: occupancy query says %d\n", per_cu); per_cu = 1; }
        (void)hipGetLastError();
        grid = cus;
    }
    if (grid < 0) return;
    (void)hipMemsetAsync((char*)d_ws + WS_CTL, 0, CTL_ZERO_BYTES, stream);
    Params p{};
    for (int i = 0; i < 32; ++i) p.in[i] = (const float*)d_in[i];
    p.out = (float*)d_out; p.ws = (unsigned char*)d_ws;
#ifndef PROBE_PHASE
#define PROBE_PHASE -1
#endif
#ifndef PROBE_ATT
#define PROBE_ATT 31
#endif
    const int nl = (PROBE_PHASE >= 0) ? 2 : 1;
    for (int li = 0; li < nl; ++li) {
        p.ph_lo = (li == 0) ? 0 : PROBE_PHASE; p.ph_hi = (nl == 2 && li == 0) ? PROBE_PHASE + 1 : N_PHASES; p.li = li; p.pad = (nl == 2 && li == 1) ? ((PROBE_PHASE == 0 ? PROBE_ATT : 31) | ((PROBE_PHASE == 5 ? PROBE_ATT : 3) << 8)) : (31 | (3 << 8));
        hipLaunchKernelGGL(fwd_kernel, dim3(grid), dim3(NWAVES * 64), LDS_BYTES, stream, p);
    }
}
```

```cpp
#include <hip/hip_runtime.h>
#include <cstdio>
#include <cstdint>

#define LAS __attribute__((address_space(3)))
#define GAS __attribute__((address_space(1)))
typedef unsigned short bf16_t;
typedef short bf16x8 __attribute__((ext_vector_type(8)));
typedef short s16x4 __attribute__((ext_vector_type(4)));
typedef float f32x2 __attribute__((ext_vector_type(2)));
typedef float f32x4 __attribute__((ext_vector_type(4)));
typedef float f32x16 __attribute__((ext_vector_type(16)));
typedef unsigned u32x2 __attribute__((ext_vector_type(2)));
typedef unsigned u32x4 __attribute__((ext_vector_type(4)));

constexpr int DM = 1024, SEQ = 8192, NB = 2, NPR = NB * SEQ;
constexpr int NSEQ = 128, NNEW = 4, NSR = NSEQ * NNEW, PAST = 2048;
constexpr int NR = NPR + NSR;
constexpr int INC = 3096, INCP = 3328, DFF = 2816;
constexpr int TC = 2048;
constexpr int TS = 2112;
constexpr int TW = 576;
constexpr float EPS = 1e-6f;
constexpr float C2 = 0.125f * 1.4426950408889634f;

constexpr size_t O_YP = 0, O_YS = 16777216, O_PKC = 17301504, O_PVC = 21495808, O_PKS = 25690112, O_PVS = 29884416,
                 O_PKW = 34078720, O_PVW = 34340864, O_PCV = 34603008, O_SKC = 34734080, O_SVC = 34865152, O_SKS = 34996224,
                 O_SVS = 35127296, O_SKW = 35258368, O_SVW = 52035584, O_SCV = 68812800, O_TOTAL = 69074944;

constexpr size_t MiB = 1u << 20;
constexpr size_t WS_CTL = 0, CTL_ZERO_BYTES = 128 * 1024;
constexpr size_t WS_WTIN = 1 * MiB, WS_WTOUT = 8 * MiB, WS_WTF1 = 10 * MiB, WS_WTF2 = 21 * MiB, WS_WTC1K = 27 * MiB, WS_WTC1V = 28 * MiB;
constexpr size_t WS_W2TK = 29 * MiB, WS_W2TV = 29 * MiB + 32768, WS_SGUW = 29 * MiB + 65536, WS_PEB = 29 * MiB + 524288;
constexpr size_t WS_ROPE = 30 * MiB, WS_MOD = 33 * MiB, WS_GATES = 37 * MiB;
constexpr size_t WS_H = 40 * MiB, WS_U = 74 * MiB, WS_V = 91 * MiB, WS_Q = 108 * MiB, WS_MIX = 125 * MiB;
constexpr size_t WS_KS = 160 * MiB, WS_VS = 168 * MiB, WS_KW = 176 * MiB, WS_VW = 184 * MiB;
constexpr size_t WS_AK = 192 * MiB, WS_AV = 330 * MiB;
constexpr size_t WS_CKS = 468 * MiB, WS_CVS = 601 * MiB, WS_CWK = 734 * MiB, WS_CWV = 771 * MiB;
constexpr size_t WS_HIDK = 808 * MiB, WS_HIDV = 843 * MiB, WS_KCC = 878 * MiB, WS_VCC = 887 * MiB;
constexpr size_t WS_X1 = 896 * MiB, WS_F = 963 * MiB, WS_END = 1056 * MiB;
constexpr int CW_BAR = 4096;
constexpr int NCROWS = 4096 + NSEQ * 4 * 128;

constexpr int RING_BYTES = 131072, LDSCTL_OFF = RING_BYTES, MISC_OFF = LDSCTL_OFF + 320, LDS_BYTES = 163840;
constexpr int NWAVES = 8;

struct Params {
    const float* in[32];
    float* out;
    unsigned char* ws;
    int ph_lo, ph_hi, li, pad;
};

__device__ __forceinline__ unsigned cvt_pk_bf16(float lo, float hi) { unsigned r; asm volatile("v_cvt_pk_bf16_f32 %0, %1, %2" : "=v"(r) : "v"(lo), "v"(hi)); return r; }
__device__ __forceinline__ float bf2f(unsigned short b) { return __builtin_bit_cast(float, (unsigned)b << 16); }
__device__ __forceinline__ float bflo(unsigned w) { return __builtin_bit_cast(float, w << 16); }
__device__ __forceinline__ float bfhi(unsigned w) { return __builtin_bit_cast(float, w & 0xffff0000u); }
__device__ __forceinline__ float fast_exp2(float x) { return __builtin_amdgcn_exp2f(x); }
__device__ __forceinline__ float fast_rcp(float x) { return __builtin_amdgcn_rcpf(x); }
__device__ __forceinline__ float sigmoidf_(float x) { return fast_rcp(1.f + fast_exp2(-1.4426950408889634f * x)); }
__device__ __forceinline__ float siluf_(float x) { return x * sigmoidf_(x); }
__device__ __forceinline__ float geluf_(float x) { const float z = 0.7978845608028654f * (x + 0.044715f * x * x * x); return x * sigmoidf_(2.f * z); }
__device__ __forceinline__ float wave_sum(float v) {
#pragma unroll
    for (int o = 1; o < 64; o <<= 1) v += __shfl_xor(v, o);
    return v;
}
__device__ __forceinline__ int crow(int r, int hi) { return (r & 3) + 8 * (r >> 2) + 4 * hi; }
template <class T> __device__ __forceinline__ T* launder_gptr(T* p) { GAS T* g = (GAS T*)p; asm volatile("" : "+s"(g)); return (T*)g; }
#define LAUNDER_GPTR(p) do { p = launder_gptr(p); } while (0)
__device__ __forceinline__ int fresh_lane() { int l; asm volatile("v_mbcnt_lo_u32_b32 %0, -1, 0\n\tv_mbcnt_hi_u32_b32 %0, -1, %0" : "=v"(l)); return l; }
#define LDS_WAIT() asm volatile("s_waitcnt lgkmcnt(0)" ::: "memory")
#define VM_WAIT() asm volatile("s_waitcnt vmcnt(0)" ::: "memory")
namespace pg8 {
#define PG8_LAS __attribute__((address_space(3)))
constexpr int BM = 256, BK = 64, HALF = 128, HTB = HALF * BK * 2  , STAGE_BYTES = 8 * HTB, NXCD = 8, WGM = 8;

__host__ __device__ __forceinline__ int lds_byte(int r, int c) { const int st = (r >> 4) * 2 + (c >> 5), rr = r & 15, cc = c & 31, ob = rr * 64 + cc * 2; return st * 1024 + (ob ^ (((ob >> 9) & 1) << 5)); }
__host__ __device__ __forceinline__ void stage_rc(int b, int& R, int& C) { const int st = b / 1024, sb = b % 1024, swz = sb ^ (((sb >> 9) & 1) << 5); R = (st >> 1) * 16 + swz / 64; C = (st & 1) * 32 + (swz % 64) / 2; }
__host__ __device__ __forceinline__ int perm32(int rho) { const int n = rho >> 4, i = rho & 15; return 8 * (i >> 2) + 4 * n + (i & 3); }

struct Unit { int pm, pn, kind; };
struct Gemm { const bf16_t* A; const bf16_t* Bt; int M, N, K, lda, ldb; };
struct StaticOrder {
    int nM, nN, nwg, G, c;
    __host__ __device__ void init(int M, int N, int G_, int c_) { nM = M / BM; nN = N / BM; nwg = nM * nN; G = G_; c = c_; }
    __device__ __forceinline__ const char* abase(const Gemm& g, const Unit& u) const { return (const char*)g.A + (size_t)u.pm * ((size_t)BM * g.lda * 2); }
    __device__ __forceinline__ const char* bbase(const Gemm& g, const Unit& u) const { return (const char*)g.Bt + (size_t)u.pn * ((size_t)BM * g.ldb * 2); }
    __host__ __device__ bool next(int i, Unit& u) const {
        u.kind = 0; const long L = (long)i * G + c; if (L >= nwg) return false;
        int wgid = (int)L; { const int q = nwg / NXCD, r = nwg % NXCD, xcd = wgid % NXCD, off = wgid / NXCD; wgid = (xcd < r ? xcd * (q + 1) : r * (q + 1) + (xcd - r) * q) + off; }
        const int nig = WGM * nN, gid = wgid / nig, fm = gid * WGM, gsz = (nM - fm) < WGM ? (nM - fm) : WGM;
        u.pm = fm + ((wgid % nig) % gsz); u.pn = (wgid % nig) / gsz; return true;
    }
    __device__ __forceinline__ void a_ready(const Unit&) const {}
    __device__ __forceinline__ void done(const Unit&) const {}
};
template <class Epi, class Sched, bool ALIGN_EPI = false, bool SP2 = false>
__device__ __forceinline__ void gemm_phase(PG8_LAS unsigned char* lds, const Gemm g, const Sched& S, const Epi& E, int wave_sgpr) {
    int tid_ = wave_sgpr * 64 + fresh_lane();
    const int tid = tid_, wid = __builtin_amdgcn_readfirstlane(tid >> 6), lane = tid & 63, wr = wid >> 2, wc = wid & 3, fr = lane & 15, fq = lane >> 4;
    const int K = g.K, nt = K / BK;
    unsigned voffA[2], voffB[2];
#pragma unroll
    for (int i = 0; i < 2; ++i) { int R, C; stage_rc(tid * 16 + i * 8192, R, C); const int Rb = Epi::PERM ? ((R & ~31) + perm32(R & 31)) : R;
        voffA[i] = (unsigned)(R * g.lda + C) * 2u; voffB[i] = (unsigned)(Rb * g.ldb + C) * 2u; }
    const size_t kstep = (size_t)(BK * 2);
    const size_t hstepA = (size_t)HALF * g.lda * 2, hstepB = (size_t)HALF * g.ldb * 2;
    const unsigned ldsw = (unsigned)wid * 1024u;
    const int aoff = lds_byte(wr * 64 + fr, fq * 8), boff = lds_byte(wc * 32 + fr, fq * 8);
#define PG8_SA(b, h) (((b) * 2 + (h)) * HTB)
#define PG8_SB(b, h) ((4 + (b) * 2 + (h)) * HTB)
#define PG8_STAGE(bufoff, gbase, voff) do { _Pragma("unroll") for (int _i = 0; _i < 2; ++_i) \
        __builtin_amdgcn_global_load_lds((const unsigned*)((const char*)(gbase) + (voff)[_i]), (PG8_LAS unsigned*)(lds + (bufoff) + ldsw + _i * 8192), 16, 0, 0); } while (0)
#define PG8_LDA(dst, b, h) do { _Pragma("unroll") for (int m = 0; m < 4; ++m) _Pragma("unroll") for (int k = 0; k < 2; ++k) dst[m][k] = *(const PG8_LAS bf16x8*)(lds + PG8_SA(b, h) + aoff + m * 2048 + k * 1024); } while (0)
#define PG8_LDB(dst, b, h) do { _Pragma("unroll") for (int n = 0; n < 2; ++n) _Pragma("unroll") for (int k = 0; k < 2; ++k) dst[n][k] = *(const PG8_LAS bf16x8*)(lds + PG8_SB(b, h) + boff + n * 2048 + k * 1024); } while (0)
#define PG8_MMA(ai, bj, At, Bt) do { __builtin_amdgcn_s_setprio(1); _Pragma("unroll") for (int m = 0; m < 4; ++m) _Pragma("unroll") for (int n = 0; n < 2; ++n) _Pragma("unroll") for (int k = 0; k < 2; ++k) \
        acc[ai][bj][m][n] = __builtin_amdgcn_mfma_f32_16x16x32_bf16(Bt[n][k], At[m][k], acc[ai][bj][m][n], 0, 0, 0); __builtin_amdgcn_s_setprio(0); } while (0)
#define PG8_WAIT_V(n) asm volatile("s_waitcnt vmcnt(" #n ")" ::: "memory")
#define PG8_WAIT_L(n) asm volatile("s_waitcnt lgkmcnt(" #n ")" ::: "memory")
#define PG8_BAR __builtin_amdgcn_s_barrier()
#define PG8_SCHED __builtin_amdgcn_sched_barrier(0)
    Unit cur, nxt; int ui = 0;
    if (!S.next(0, cur)) return;
    f32x4 acc[2][2][4][2];
#pragma unroll
    for (int a = 0; a < 2; ++a)
#pragma unroll
        for (int b = 0; b < 2; ++b)
#pragma unroll
            for (int m = 0; m < 4; ++m)
#pragma unroll
                for (int n = 0; n < 2; ++n) acc[a][b][m][n] = (f32x4){0.f, 0.f, 0.f, 0.f};
    bf16x8 At[4][2], B0[2][2], B1[2][2];
    const char* cA = S.abase(g, cur); const char* cB = S.bbase(g, cur);
    S.a_ready(cur);
    if constexpr (SP2) {
        PG8_STAGE(PG8_SB(0, 0), cB, voffB); PG8_STAGE(PG8_SB(0, 1), cB + hstepB, voffB); PG8_STAGE(PG8_SA(0, 0), cA, voffA); PG8_STAGE(PG8_SA(0, 1), cA + hstepA, voffA);
        if (wr == 1) PG8_BAR;
        PG8_WAIT_V(2); PG8_BAR;
        PG8_STAGE(PG8_SB(1, 0), cB + kstep, voffB); PG8_STAGE(PG8_SA(1, 0), cA + kstep, voffA); PG8_STAGE(PG8_SB(1, 1), cB + hstepB + kstep, voffB);
        PG8_WAIT_V(6); PG8_BAR;
    } else {
        PG8_STAGE(PG8_SB(0, 0), cB, voffB); PG8_STAGE(PG8_SA(0, 0), cA, voffA); PG8_STAGE(PG8_SB(0, 1), cB + hstepB, voffB); PG8_STAGE(PG8_SA(0, 1), cA + hstepA, voffA);
        if (wr == 1) PG8_BAR;
        PG8_WAIT_V(4); PG8_BAR;
        PG8_STAGE(PG8_SB(1, 0), cB + kstep, voffB); PG8_STAGE(PG8_SA(1, 0), cA + kstep, voffA); PG8_STAGE(PG8_SB(1, 1), cB + hstepB + kstep, voffB);
        PG8_WAIT_V(6); PG8_BAR;
    }
    for (;;) {
        const bool has_next = S.next(ui + 1, nxt);
        const char* nA = has_next ? S.abase(g, nxt) : cA; const char* nB = has_next ? S.bbase(g, nxt) : cB;
        for (int t = 0; t < nt; t += 2) {
            const bool last = (t == nt - 2);
            const char* a1 = cA + (size_t)(t + 1) * kstep;
            const char* a2 = last ? nA : cA + (size_t)(t + 2) * kstep; const char* b2 = last ? nB : cB + (size_t)(t + 2) * kstep;
            const char* a3 = a2 + kstep; const char* b3 = b2 + kstep;
            if (last && has_next) S.a_ready(nxt);
            if constexpr (SP2) {
            PG8_LDB(B0, 0, 0); PG8_LDB(B1, 0, 1); PG8_SCHED; PG8_LDA(At, 0, 0); PG8_STAGE(PG8_SA(1, 1), a1 + hstepA, voffA);
            PG8_WAIT_V(8); PG8_WAIT_L(0); PG8_BAR; PG8_MMA(0, 0, At, B0); PG8_MMA(0, 1, At, B1); PG8_BAR; PG8_SCHED;
            PG8_LDA(At, 0, 1); PG8_STAGE(PG8_SB(0, 0), b2, voffB); PG8_STAGE(PG8_SB(0, 1), b2 + hstepB, voffB); PG8_STAGE(PG8_SA(0, 0), a2, voffA);
            PG8_WAIT_V(8); PG8_WAIT_L(0); PG8_BAR; PG8_MMA(1, 0, At, B0); PG8_MMA(1, 1, At, B1); PG8_BAR; PG8_SCHED;
            PG8_LDB(B0, 1, 0); PG8_LDB(B1, 1, 1); PG8_SCHED; PG8_LDA(At, 1, 0); PG8_STAGE(PG8_SA(0, 1), a2 + hstepA, voffA);
            PG8_WAIT_V(8); PG8_WAIT_L(0); PG8_BAR; PG8_MMA(0, 0, At, B0); PG8_MMA(0, 1, At, B1); PG8_BAR; PG8_SCHED;
            PG8_LDA(At, 1, 1); PG8_STAGE(PG8_SB(1, 0), b3, voffB); PG8_STAGE(PG8_SB(1, 1), b3 + hstepB, voffB); PG8_STAGE(PG8_SA(1, 0), a3, voffA);
            PG8_WAIT_V(8); PG8_WAIT_L(0); PG8_BAR; PG8_MMA(1, 0, At, B0); PG8_MMA(1, 1, At, B1); PG8_BAR; PG8_SCHED;
            } else {
            PG8_LDB(B0, 0, 0); PG8_SCHED; PG8_LDA(At, 0, 0); PG8_STAGE(PG8_SA(1, 1), a1 + hstepA, voffA);
            PG8_WAIT_L(8); PG8_BAR; PG8_WAIT_L(0); PG8_MMA(0, 0, At, B0); PG8_BAR; PG8_SCHED;
            PG8_LDB(B1, 0, 1); PG8_STAGE(PG8_SB(0, 0), b2, voffB);
            PG8_BAR; PG8_WAIT_L(0); PG8_MMA(0, 1, At, B1); PG8_BAR;
            PG8_LDA(At, 0, 1); PG8_STAGE(PG8_SA(0, 0), a2, voffA);
            PG8_BAR; PG8_WAIT_L(0); PG8_MMA(1, 0, At, B0); PG8_BAR; PG8_SCHED;
            PG8_STAGE(PG8_SB(0, 1), b2 + hstepB, voffB);
            PG8_WAIT_V(6); PG8_BAR; PG8_MMA(1, 1, At, B1); PG8_BAR;
            PG8_LDB(B0, 1, 0); PG8_SCHED; PG8_LDA(At, 1, 0); PG8_STAGE(PG8_SA(0, 1), a2 + hstepA, voffA);
            PG8_WAIT_L(8); PG8_BAR; PG8_WAIT_L(0); PG8_MMA(0, 0, At, B0); PG8_BAR; PG8_SCHED;
            PG8_LDB(B1, 1, 1); PG8_STAGE(PG8_SB(1, 0), b3, voffB);
            PG8_BAR; PG8_WAIT_L(0); PG8_MMA(0, 1, At, B1); PG8_BAR;
            PG8_LDA(At, 1, 1); PG8_STAGE(PG8_SA(1, 0), a3, voffA);
            PG8_BAR; PG8_WAIT_L(0); PG8_MMA(1, 0, At, B0); PG8_BAR; PG8_SCHED;
            PG8_STAGE(PG8_SB(1, 1), b3 + hstepB, voffB);
            PG8_WAIT_V(6); PG8_BAR; PG8_MMA(1, 1, At, B1); PG8_BAR;
            }
        }
        if constexpr (ALIGN_EPI) { if (wr == 0) PG8_BAR; }
        if constexpr (!Epi::AFTER_DRAIN) { E(acc, cur, wr, wc, fr, fq); S.done(cur); }
        if (!has_next) break;
#pragma unroll
        for (int a = 0; a < 2; ++a)
#pragma unroll
            for (int b = 0; b < 2; ++b)
#pragma unroll
                for (int m = 0; m < 4; ++m)
#pragma unroll
                    for (int n = 0; n < 2; ++n) acc[a][b][m][n] = (f32x4){0.f, 0.f, 0.f, 0.f};
        cur = nxt; cA = nA; cB = nB; ++ui;
        if constexpr (ALIGN_EPI) { if (wr == 1) PG8_BAR; }
    }
    PG8_WAIT_V(0);
    if constexpr (!ALIGN_EPI) { if (wr == 0) PG8_BAR; }
    PG8_BAR;
    if constexpr (Epi::AFTER_DRAIN) { E.fused(acc, cur, wr, wc, fr, fq, lds, wid, lane); S.done(cur); }
#undef PG8_SA
#undef PG8_SB
#undef PG8_STAGE
#undef PG8_LDA
#undef PG8_LDB
#undef PG8_MMA
#undef PG8_WAIT_V
#undef PG8_WAIT_L
#undef PG8_BAR
#undef PG8_SCHED
}
}

#define XB_TMO      128
#define XB_XCNT(j)  (256  + 64 * (j))
#define XB_XSUB(j)  (1280 + 64 * (j))
#define XB_XGEN(j)  (2304 + 64 * (j))
#define XB_TOP      3328
#define XB_TOPGEN   3392
#define XCD_BAR_WORDS 3456
#define XB_SPIN_CAP (1u << 18)

__device__ __forceinline__ unsigned xb_ld(unsigned* p)              { return __hip_atomic_load(p, __ATOMIC_RELAXED, __HIP_MEMORY_SCOPE_AGENT); }
__device__ __forceinline__ unsigned xb_add(unsigned* p, unsigned v) { return __hip_atomic_fetch_add(p, v, __ATOMIC_RELAXED, __HIP_MEMORY_SCOPE_AGENT); }
__device__ __forceinline__ unsigned xb_xcc_id() { return (unsigned)__builtin_amdgcn_s_getreg((3 << 11) | 20) & 0xFu; }
#define XB_SPIN(cond, bar) do { unsigned _sp = 0; while (cond) { __builtin_amdgcn_s_sleep(1); \
    if ((++_sp & 255u) == 0u) { if (xb_ld(&(bar)[XB_TMO])) break; if (_sp > XB_SPIN_CAP) { atomicAdd(&(bar)[XB_TMO], 1u); break; } } } } while (0)

struct XcdBarrier {
    unsigned* bar; unsigned x;
    volatile LAS unsigned* st;
};

__device__ __forceinline__ XcdBarrier xcd_barrier_post(unsigned* bar, volatile LAS unsigned* st) {
    XcdBarrier b; b.bar = bar; b.x = xb_xcc_id(); b.st = st;
    if (threadIdx.x == 0) (void)xb_add(&bar[XB_XCNT(b.x)], 1u);
    return b;
}
__device__ __forceinline__ void xcd_barrier_complete(unsigned* bar, unsigned x, unsigned& nloc, unsigned& nx) {
    const unsigned G = gridDim.x * gridDim.y * gridDim.z;
    unsigned sum, cnt, mine, sp = 0u;
    for (;;) {
        sum = 0u; cnt = 0u; mine = 0u;
#pragma unroll
        for (unsigned j = 0; j < 16; ++j) { const unsigned c = xb_ld(&bar[XB_XCNT(j)]); sum += c; cnt += (c > 0u) ? 1u : 0u; mine = (j == x) ? c : mine; }
        if (sum == G) break;
        __builtin_amdgcn_s_sleep(1);
        if ((++sp & 255u) == 0u) { if (xb_ld(&bar[XB_TMO])) break; if (sp > XB_SPIN_CAP) { atomicAdd(&bar[XB_TMO], 1u); break; } }
    }
    nloc = mine > 0u ? mine : 1u; nx = cnt > 0u ? cnt : 1u;
}

__device__ __forceinline__ void xcd_barrier(const XcdBarrier& b, int wave_sgpr) {
    asm volatile("s_waitcnt vmcnt(0)" ::: "memory");
    __syncthreads();
    if (wave_sgpr == 0 && fresh_lane() == 0) {
        unsigned* bar = b.bar;
        __builtin_amdgcn_s_waitcnt(0);
        unsigned nloc = b.st[0], nx = b.st[1];
        if (nloc == 0u) { xcd_barrier_complete(bar, b.x, nloc, nx); b.st[0] = nloc; b.st[1] = nx; }
        const unsigned old = xb_add(&bar[XB_XSUB(b.x)], 1u);
        const unsigned gen = old / nloc;
        if (old + 1u == (gen + 1u) * nloc) {
            __builtin_amdgcn_fence(__ATOMIC_RELEASE, "agent");
            asm volatile("s_waitcnt vmcnt(0)" ::: "memory");
            const unsigned og = xb_add(&bar[XB_TOP], 1u);
            const unsigned tg = og / nx;
            if (og + 1u == (tg + 1u) * nx) xb_add(&bar[XB_TOPGEN], 1u);
            else XB_SPIN(xb_ld(&bar[XB_TOPGEN]) == tg, bar);
            __builtin_amdgcn_fence(__ATOMIC_ACQUIRE, "agent");
            xb_add(&bar[XB_XGEN(b.x)], 1u);
            asm volatile("s_waitcnt vmcnt(0)" ::: "memory");
        } else {
            XB_SPIN(xb_ld(&bar[XB_XGEN(b.x)]) == gen, bar);
            __builtin_amdgcn_fence(__ATOMIC_ACQUIRE, "agent");
            asm volatile("s_waitcnt vmcnt(0)" ::: "memory");
        }
    }
    __syncthreads();
}

namespace pg8 {
using ::Params;

__device__ __forceinline__ int mod_row(int r) { return r < NPR ? (r >> 13) : 2 + ((r - NPR) >> 2); }

struct EpiProj {
    static constexpr bool PERM = true, AFTER_DRAIN = false;
    const Params* P;
    __device__ __forceinline__ void operator()(const f32x4 (&acc)[2][2][4][2], const Unit& u, int wr, int wc, int fr, int fq) const {
        asm volatile("" : "+v"(fr), "+v"(fq));
        const int G = u.pn * 4 + wc;
        if (G > 48) return;
        unsigned char* ws = P->ws; LAUNDER_GPTR(ws); float* out = P->out;
        const bool samp = u.pm >= 64;
        const int dd0 = 8 * fq;
        const int kind6 = (G - 24) >> 2, gk = (G - 24) & 3;
        const bool isnr = (G >= 16 && G < 24) || (G >= 24 && G < 48 && (kind6 & 1) == 0);
        const float* gain = nullptr;
        if (G >= 8 && G < 16) gain = P->in[16] + (G - 8) * 64;
        else if (G >= 16 && G < 24) gain = P->in[19];
        else if (isnr) gain = P->in[20 + (kind6 >> 1)];
        const float* rope = (const float*)(ws + WS_ROPE);
#pragma unroll
        for (int ai = 0; ai < 2; ++ai)
#pragma unroll
            for (int m = 0; m < 4; ++m) {
                const int r = u.pm * 256 + ai * 128 + wr * 64 + m * 16 + fr;
                const int s = r - NPR;
                const int b = r >> 13, t = r & 8191;
                const int pos = samp ? PAST + (s & 3) : t;
                f32x4 v[2][2];
#pragma unroll
                for (int bj = 0; bj < 2; ++bj)
#pragma unroll
                    for (int n = 0; n < 2; ++n) v[bj][n] = acc[ai][bj][m][n];
                if (G < 8) {
                    bf16_t* U = (bf16_t*)(ws + WS_U) + (size_t)r * 512 + G * 64 + dd0;
#pragma unroll
                    for (int bj = 0; bj < 2; ++bj) { u32x4 w;
                        w.x = cvt_pk_bf16(geluf_(v[bj][0][0]), geluf_(v[bj][0][1])); w.y = cvt_pk_bf16(geluf_(v[bj][0][2]), geluf_(v[bj][0][3]));
                        w.z = cvt_pk_bf16(geluf_(v[bj][1][0]), geluf_(v[bj][1][1])); w.w = cvt_pk_bf16(geluf_(v[bj][1][2]), geluf_(v[bj][1][3]));
                        *(u32x4*)(U + 32 * bj) = w; }
                } else if (G < 16) {
                    float ss = 0.f;
#pragma unroll
                    for (int bj = 0; bj < 2; ++bj)
#pragma unroll
                        for (int n = 0; n < 2; ++n)
#pragma unroll
                            for (int i = 0; i < 4; ++i) { const float g_ = geluf_(v[bj][n][i]); v[bj][n][i] = g_; ss += g_ * g_; }
                    ss += __shfl_xor(ss, 16); ss += __shfl_xor(ss, 32);
                    const float rstd = 1.0f / sqrtf(ss * (1.f / 64.f) + EPS);
                    bf16_t* V = (bf16_t*)(ws + WS_V) + (size_t)r * 512 + (G - 8) * 64 + dd0;
                    float* cv = nullptr;
                    if (samp) cv = out + O_SCV + (size_t)s * 512 + (G - 8) * 64 + dd0;
                    else if (t >= SEQ - 128) cv = out + O_PCV + ((size_t)b * 128 + (t - (SEQ - 128))) * 512 + (G - 8) * 64 + dd0;
#pragma unroll
                    for (int bj = 0; bj < 2; ++bj) { const f32x4 g0_ = *(const f32x4*)(gain + 32 * bj + dd0), g1_ = *(const f32x4*)(gain + 32 * bj + dd0 + 4); f32x4 a = v[bj][0] * rstd * g0_, c = v[bj][1] * rstd * g1_; u32x4 w;
                        w.x = cvt_pk_bf16(a[0], a[1]); w.y = cvt_pk_bf16(a[2], a[3]); w.z = cvt_pk_bf16(c[0], c[1]); w.w = cvt_pk_bf16(c[2], c[3]);
                        *(u32x4*)(V + 32 * bj) = w;
                        if (cv) { *(f32x4*)(cv + 32 * bj) = a; *(f32x4*)(cv + 32 * bj + 4) = c; } }
                } else if (G < 48) {
                    if (isnr) {
                        float ss = 0.f;
#pragma unroll
                        for (int bj = 0; bj < 2; ++bj)
#pragma unroll
                            for (int n = 0; n < 2; ++n)
#pragma unroll
                                for (int i = 0; i < 4; ++i) ss += v[bj][n][i] * v[bj][n][i];
                        ss += __shfl_xor(ss, 16); ss += __shfl_xor(ss, 32);
                        const float rstd = 1.0f / sqrtf(ss * (1.f / 64.f) + EPS);
                        const float* rp = rope + (size_t)pos * 64 + dd0;
#pragma unroll
                        for (int n = 0; n < 2; ++n) { const f32x4 cs = *(const f32x4*)(rp + 4 * n), sn = *(const f32x4*)(rp + 32 + 4 * n);
                            const f32x4 x1 = v[0][n] * rstd * *(const f32x4*)(gain + dd0 + 4 * n), x2 = v[1][n] * rstd * *(const f32x4*)(gain + 32 + dd0 + 4 * n);
                            v[0][n] = x1 * cs - x2 * sn; v[1][n] = x2 * cs + x1 * sn; }
                    }
                    if (G < 24) {
                        bf16_t* Q = (bf16_t*)(ws + WS_Q) + (size_t)r * 512 + (G - 16) * 64 + dd0;
#pragma unroll
                        for (int bj = 0; bj < 2; ++bj) { const f32x4 a = v[bj][0] * C2, c = v[bj][1] * C2; u32x4 w;
                            w.x = cvt_pk_bf16(a[0], a[1]); w.y = cvt_pk_bf16(a[2], a[3]); w.z = cvt_pk_bf16(c[0], c[1]); w.w = cvt_pk_bf16(c[2], c[3]);
                            *(u32x4*)(Q + 32 * bj) = w; }
                    } else {
                        float* o32 = nullptr; bf16_t* hm = nullptr;
                        const int rr = samp ? s : r;
                        const int sg = samp ? ((s >> 2) * 4 + gk) : 0, si = s & 3;
                        const size_t pofs = ((size_t)(b * 4 + gk) * SEQ + t) * 64;
                        switch (kind6) {
                        case 0: o32 = out + (samp ? O_SKC : O_PKC) + ((size_t)rr * 4 + gk) * 64; if (!samp) hm = (bf16_t*)(ws + WS_AK) + pofs; break;
                        case 1: o32 = out + (samp ? O_SVC : O_PVC) + ((size_t)rr * 4 + gk) * 64; if (!samp) hm = (bf16_t*)(ws + WS_AV) + pofs; break;
                        case 2: o32 = out + (samp ? O_SKS : O_PKS) + ((size_t)rr * 4 + gk) * 64;
                                hm = samp ? (bf16_t*)(ws + WS_CKS) + ((size_t)sg * 64 + si) * 64 : (bf16_t*)(ws + WS_KS) + pofs; break;
                        case 3: o32 = out + (samp ? O_SVS : O_PVS) + ((size_t)rr * 4 + gk) * 64;
                                hm = samp ? (bf16_t*)(ws + WS_CVS) + ((size_t)sg * 64 + si) * 64 : (bf16_t*)(ws + WS_VS) + pofs; break;
                        case 4: if (samp) o32 = out + O_SKW + (((size_t)(s >> 2) * 512 + 508 + si) * 4 + gk) * 64;
                                else if (t >= SEQ - 512) o32 = out + O_PKW + (((size_t)b * 512 + (t - (SEQ - 512))) * 4 + gk) * 64;
                                hm = samp ? (bf16_t*)(ws + WS_CWK) + ((size_t)sg * 64 + si) * 64 : (bf16_t*)(ws + WS_KW) + pofs; break;
                        default: if (samp) o32 = out + O_SVW + (((size_t)(s >> 2) * 512 + 508 + si) * 4 + gk) * 64;
                                else if (t >= SEQ - 512) o32 = out + O_PVW + (((size_t)b * 512 + (t - (SEQ - 512))) * 4 + gk) * 64;
                                hm = samp ? (bf16_t*)(ws + WS_CWV) + ((size_t)sg * 64 + si) * 64 : (bf16_t*)(ws + WS_VW) + pofs; break;
                        }
#pragma unroll
                        for (int bj = 0; bj < 2; ++bj) {
                            if (o32) { *(f32x4*)(o32 + 32 * bj + dd0) = v[bj][0]; *(f32x4*)(o32 + 32 * bj + dd0 + 4) = v[bj][1]; }
                            if (hm) { u32x4 w; w.x = cvt_pk_bf16(v[bj][0][0], v[bj][0][1]); w.y = cvt_pk_bf16(v[bj][0][2], v[bj][0][3]);
                                w.z = cvt_pk_bf16(v[bj][1][0], v[bj][1][1]); w.w = cvt_pk_bf16(v[bj][1][2], v[bj][1][3]);
                                *(u32x4*)(hm + 32 * bj + dd0) = w; } }
                    }
                } else {
                    if (fq < 3) { float* gt = (float*)(ws + WS_GATES) + (size_t)r * 24 + dd0;
#pragma unroll
                        for (int n = 0; n < 2; ++n) { f32x4 o; o[0] = sigmoidf_(v[0][n][0]); o[1] = sigmoidf_(v[0][n][1]); o[2] = sigmoidf_(v[0][n][2]); o[3] = sigmoidf_(v[0][n][3]);
                            *(f32x4*)(gt + 4 * n) = o; } }
                }
            }
    }
};

template <int WHICH> struct EpiResid {
    static constexpr bool PERM = true, AFTER_DRAIN = false;
    const Params* P;
    __device__ __forceinline__ void operator()(const f32x4 (&acc)[2][2][4][2], const Unit& u, int wr, int wc, int fr, int fq) const {
        unsigned char* ws = P->ws; LAUNDER_GPTR(ws);
        const float* MOD = (const float*)(ws + WS_MOD);
        float* X1 = (float*)(ws + WS_X1);
        const int col0 = u.pn * 256 + wc * 32 + 8 * fq;
#pragma unroll
        for (int ai = 0; ai < 2; ++ai)
#pragma unroll
            for (int m = 0; m < 4; ++m) {
                const int r = u.pm * 256 + ai * 128 + wr * 64 + m * 16 + fr;
                const float* gate = MOD + (size_t)mod_row(r) * 6144 + (WHICH == 0 ? 2048 : 5120) + col0;
                const float* res = (WHICH == 0) ? (r < NPR ? P->in[0] + (size_t)r * DM : P->in[1] + (size_t)(r - NPR) * DM) + col0 : X1 + (size_t)r * DM + col0;
                float* dst = (WHICH == 0) ? X1 + (size_t)r * DM + col0 : P->out + (size_t)r * DM + col0;
#pragma unroll
                for (int bj = 0; bj < 2; ++bj)
#pragma unroll
                    for (int n = 0; n < 2; ++n) { const int o = bj * 128 + 4 * n;
                        const f32x4 g = *(const f32x4*)(gate + o), x = *(const f32x4*)(res + o);
                        *(f32x4*)(dst + o) = x + g * acc[ai][bj][m][n]; }
            }
    }
};

struct EpiSwiglu {
    static constexpr bool PERM = true, AFTER_DRAIN = false;
    const Params* P;
    __device__ __forceinline__ void operator()(const f32x4 (&acc)[2][2][4][2], const Unit& u, int wr, int wc, int fr, int fq) const {
        bf16_t* F = (bf16_t*)(P->ws + WS_F);
        const int col0 = u.pn * 128 + wc * 32 + 8 * fq;
#pragma unroll
        for (int ai = 0; ai < 2; ++ai)
#pragma unroll
            for (int m = 0; m < 4; ++m) {
                const int r = u.pm * 256 + ai * 128 + wr * 64 + m * 16 + fr;
                const f32x4 a0 = acc[ai][0][m][0], a1 = acc[ai][0][m][1], b0 = acc[ai][1][m][0], b1 = acc[ai][1][m][1];
                u32x4 w;
                w.x = cvt_pk_bf16(siluf_(a0[0]) * b0[0], siluf_(a0[1]) * b0[1]); w.y = cvt_pk_bf16(siluf_(a0[2]) * b0[2], siluf_(a0[3]) * b0[3]);
                w.z = cvt_pk_bf16(siluf_(a1[0]) * b1[0], siluf_(a1[1]) * b1[1]); w.w = cvt_pk_bf16(siluf_(a1[2]) * b1[2], siluf_(a1[3]) * b1[3]);
                *(u32x4*)(F + (size_t)r * DFF + col0) = w;
            }
    }
};

struct EpiCmp {
    static constexpr bool PERM = true, AFTER_DRAIN = false;
    bf16_t* HIDK; bf16_t* HIDV; const float* bias;
    __device__ __forceinline__ void operator()(const f32x4 (&acc)[2][2][4][2], const Unit& u, int wr, int wc, int fr, int fq) const {
        asm volatile("" : "+v"(fr), "+v"(fq));
        const int col0 = wc * 32 + 8 * fq;
        bf16_t* HID = u.kind ? HIDV : HIDK;
        f32x4 bv[2][2];
#pragma unroll
        for (int bj = 0; bj < 2; ++bj)
#pragma unroll
            for (int n = 0; n < 2; ++n) bv[bj][n] = *(const f32x4*)(bias + u.kind * 256 + col0 + bj * 128 + 4 * n);
#pragma unroll
        for (int ai = 0; ai < 2; ++ai)
#pragma unroll
            for (int m = 0; m < 4; ++m) {
                const int r = u.pm * 256 + ai * 128 + wr * 64 + m * 16 + fr;
#pragma unroll
                for (int bj = 0; bj < 2; ++bj) { const f32x4 a = acc[ai][bj][m][0] + bv[bj][0], c = acc[ai][bj][m][1] + bv[bj][1]; u32x4 w;
                    w.x = cvt_pk_bf16(geluf_(a[0]), geluf_(a[1])); w.y = cvt_pk_bf16(geluf_(a[2]), geluf_(a[3]));
                    w.z = cvt_pk_bf16(geluf_(c[0]), geluf_(c[1])); w.w = cvt_pk_bf16(geluf_(c[2]), geluf_(c[3]));
                    *(u32x4*)(HID + (size_t)r * 256 + col0 + bj * 128) = w; }
            }
    }
};
template <int MODE> struct CmpOrder {
    const char* ak; const char* av; const char* bk; const char* bv; int G, c;
    __device__ __forceinline__ const char* abase(const Gemm&, const Unit& u) const { return ak + (ptrdiff_t)u.kind * (av - ak) + (size_t)u.pm * ((size_t)BM * 1024 * 2); }
    __device__ __forceinline__ const char* bbase(const Gemm&, const Unit& u) const { return bk + (ptrdiff_t)u.kind * (bv - bk); }
    __device__ __forceinline__ bool next(int i, Unit& u) const {
        const int L = i * G + c; u.pn = 0;
        if (MODE == 0) { if (L >= 512) return false; u.kind = L >> 8; u.pm = 16 + (L & 255); return true; }
        if (L >= 32) return false; u.kind = L >> 4; u.pm = L & 15; return true;
    }
    __device__ __forceinline__ void a_ready(const Unit&) const {}
    __device__ __forceinline__ void done(const Unit&) const {}
};
}
struct Ctx { LAS unsigned char* lds; int tid, lane, wave, nblk, blk; };

__device__ __forceinline__ unsigned pk2(float lo, float hi) { return cvt_pk_bf16(lo, hi); }

__device__ __forceinline__ void transpose_item(const float* W, int K, int N, bf16_t* WT, int orow0, int n0, int kb, LAS float* scr, int lane) {
    const int k0 = 64 * kb;
    { float x[32]; const int n = n0 + (lane & 31); const float* wp = W + (size_t)k0 * N; const unsigned lo = (unsigned)((lane >> 5) * N + n);
#pragma unroll
      for (int i = 0; i < 32; ++i) x[i] = (n < N) ? (wp + (size_t)(2 * i) * N)[lo] : 0.f;
#pragma unroll
      for (int i = 0; i < 32; ++i) scr[(2 * i + (lane >> 5)) * 33 + (lane & 31)] = x[i]; }
    LDS_WAIT(); asm volatile("" ::: "memory");
    const int c = lane & 7;
#pragma unroll
    for (int j = 0; j < 4; ++j) { const int n = (lane >> 3) + 8 * j; const LAS float* s = scr + (8 * c) * 33 + n;
        u32x4 o; o.x = pk2(s[0 * 33], s[1 * 33]); o.y = pk2(s[2 * 33], s[3 * 33]); o.z = pk2(s[4 * 33], s[5 * 33]); o.w = pk2(s[6 * 33], s[7 * 33]);
        *(u32x4*)(WT + (size_t)(orow0 + n) * K + k0 + 8 * c) = o; }
    LDS_WAIT(); asm volatile("" ::: "memory");
}

#define MFMA32(a, b, c) __builtin_amdgcn_mfma_f32_32x32x16_bf16(a, b, c, 0, 0, 0)
__device__ __forceinline__ void phase_prologue(const Params& P, const Ctx& C, int parts) {
    unsigned char* ws = P.ws; LAUNDER_GPTR(ws); float* out = P.out;
    const int lane = fresh_lane(), wave = C.wave, tid = wave * 64 + lane;
    if (parts & 1)
    for (int item = C.blk; item < 192; item += C.nblk) {
        const int n0 = item * 32, r32 = lane & 31, hi = lane >> 5;
        LAS float* R = (LAS float*)C.lds;
        f32x16 acc[5];
#pragma unroll
        for (int rt = 0; rt < 5; ++rt) acc[rt] = (f32x16){0.f, 0.f, 0.f, 0.f, 0.f, 0.f, 0.f, 0.f, 0.f, 0.f, 0.f, 0.f, 0.f, 0.f, 0.f, 0.f};
        const float* wcol = P.in[11] + n0 + r32;
#pragma unroll 2
        for (int ks = 0; ks < 8; ++ks) {
            const int k0 = wave * 128 + ks * 16 + 8 * hi;
            float wv[8];
#pragma unroll
            for (int i = 0; i < 8; ++i) wv[i] = wcol[(size_t)(k0 + i) * 6144];
            f32x4 cv[5][2];
#pragma unroll
            for (int rt = 0; rt < 5; ++rt) { const int r = rt * 32 + r32;
                const float* cp = (r < 2) ? P.in[9] + r * 1024 + k0 : P.in[10] + (size_t)((r < 130 ? r : 2) - 2) * 1024 + k0;
                cv[rt][0] = *(const f32x4*)cp; cv[rt][1] = *(const f32x4*)(cp + 4);
                if (r >= 130) { cv[rt][0] = (f32x4){0.f, 0.f, 0.f, 0.f}; cv[rt][1] = cv[rt][0]; } }
            u32x4 bh, bl;
#pragma unroll
            for (int p = 0; p < 4; ++p) { const float x0 = wv[2 * p], x1 = wv[2 * p + 1]; const unsigned h = cvt_pk_bf16(x0, x1);
                bh[p] = h; bl[p] = cvt_pk_bf16(x0 - __uint_as_float(h << 16), x1 - __uint_as_float(h & 0xffff0000u)); }
#pragma unroll
            for (int rt = 0; rt < 5; ++rt) { u32x4 ah, al;
#pragma unroll
                for (int p = 0; p < 4; ++p) { const float x0 = siluf_(cv[rt][p >> 1][2 * (p & 1)]), x1 = siluf_(cv[rt][p >> 1][2 * (p & 1) + 1]); const unsigned h = cvt_pk_bf16(x0, x1);
                    ah[p] = h; al[p] = cvt_pk_bf16(x0 - __uint_as_float(h << 16), x1 - __uint_as_float(h & 0xffff0000u)); }
                acc[rt] = MFMA32(__builtin_bit_cast(bf16x8, ah), __builtin_bit_cast(bf16x8, bh), acc[rt]);
                acc[rt] = MFMA32(__builtin_bit_cast(bf16x8, ah), __builtin_bit_cast(bf16x8, bl), acc[rt]);
                acc[rt] = MFMA32(__builtin_bit_cast(bf16x8, al), __builtin_bit_cast(bf16x8, bh), acc[rt]); }
        }
        __syncthreads();
        if (wave >= 4) {
#pragma unroll
            for (int rt = 0; rt < 5; ++rt)
#pragma unroll
                for (int r = 0; r < 16; ++r) R[((wave - 4) * 80 + rt * 16 + r) * 64 + lane] = acc[rt][r]; }
        __syncthreads();
        if (wave < 4) {
#pragma unroll
            for (int rt = 0; rt < 5; ++rt)
#pragma unroll
                for (int r = 0; r < 16; ++r) R[(wave * 80 + rt * 16 + r) * 64 + lane] += acc[rt][r]; }
        __syncthreads();
        for (int o = tid; o < 80 * 64; o += 512) { const int idx = o >> 6, ln = o & 63, r = idx & 15;
            const int row = (idx >> 4) * 32 + (r & 3) + 8 * (r >> 2) + 4 * (ln >> 5), col = n0 + (ln & 31);
            if (row < 130) ((float*)(ws + WS_MOD))[(size_t)row * 6144 + col] = ((R[idx * 64 + ln] + R[(80 + idx) * 64 + ln]) + (R[(160 + idx) * 64 + ln] + R[(240 + idx) * 64 + ln])) + P.in[12][col]; }
    }
    __syncthreads();
    if (parts & 2) {
        LAS float* scr = (LAS float*)(C.lds + wave * 16384);
        const int gw = C.blk * NWAVES + wave, NGW = C.nblk * NWAVES;
        constexpr int I_IN = 16 * 104, I_OUT = 16 * 32, I_F1 = 16 * 176, I_F2 = 44 * 32, I_C1 = 32 * 8, I_W2 = 4 * 2;
        constexpr int NIT = I_IN + I_OUT + I_F1 + I_F2 + 2 * I_C1 + 2 * I_W2;
        for (int it = gw; it < NIT; it += NGW) {
            int r = it;
            if (r < I_IN) { const int kb = r / 104, nb = r % 104, n0 = 32 * nb, pn = n0 >> 8, wi = n0 & 255, wcq = wi >> 6, bjq = (wi & 63) >> 5;
                transpose_item(P.in[15], 1024, INC, (bf16_t*)(ws + WS_WTIN), 256 * pn + 128 * bjq + 32 * wcq, n0, kb, scr, lane); continue; } r -= I_IN;
            if (r < I_OUT) { transpose_item(P.in[29], 1024, 1024, (bf16_t*)(ws + WS_WTOUT), 32 * (r % 32), 32 * (r % 32), r / 32, scr, lane); continue; } r -= I_OUT;
            if (r < I_F1) { const int kb = r / 176, pg = r % 176, p0 = 32 * pg, pn = p0 >> 8, pp = p0 & 255, bj = pp >> 7, rest = pp & 127;
                transpose_item(P.in[30], 1024, 2 * DFF, (bf16_t*)(ws + WS_WTF1), p0, (bj ? DFF : 0) + 128 * pn + rest, kb, scr, lane); continue; } r -= I_F1;
            if (r < I_F2) { transpose_item(P.in[31], DFF, 1024, (bf16_t*)(ws + WS_WTF2), 32 * (r % 32), 32 * (r % 32), r / 32, scr, lane); continue; } r -= I_F2;
            if (r < I_C1) { transpose_item(P.in[25], 2048, 256, (bf16_t*)(ws + WS_WTC1K), 32 * (r % 8), 32 * (r % 8), r / 8, scr, lane); continue; } r -= I_C1;
            if (r < I_C1) { transpose_item(P.in[27], 2048, 256, (bf16_t*)(ws + WS_WTC1V), 32 * (r % 8), 32 * (r % 8), r / 8, scr, lane); continue; } r -= I_C1;
            if (r < I_W2) { transpose_item(P.in[26], 256, 64, (bf16_t*)(ws + WS_W2TK), 32 * (r % 2), 32 * (r % 2), r / 2, scr, lane); continue; } r -= I_W2;
            transpose_item(P.in[28], 256, 64, (bf16_t*)(ws + WS_W2TV), 32 * (r % 2), 32 * (r % 2), r / 2, scr, lane);
        }
    }
    const int gt = C.blk * 512 + tid, NGT = C.nblk * 512;
    if (parts & 4) { float* rope = (float*)(ws + WS_ROPE);
      for (int e = gt; e < 8192 * 32; e += NGT) { const int pos = e >> 5, d = e & 31;
          const double inv = pow(10000.0, -(double)d / 32.0); const double ang = (double)pos * inv;
          rope[(size_t)pos * 64 + d] = (float)cos(ang); rope[(size_t)pos * 64 + 32 + d] = (float)sin(ang); } }
    if ((parts & 4) && C.blk == 0 && tid < 64) { float gq = fabsf(P.in[19][tid]), gk = fmaxf(fabsf(P.in[20][tid]), fmaxf(fabsf(P.in[21][tid]), fabsf(P.in[22][tid])));
#pragma unroll
        for (int o = 1; o < 64; o <<= 1) { gq = fmaxf(gq, __shfl_xor(gq, o)); gk = fmaxf(gk, __shfl_xor(gk, o)); }
        if (tid == 0) ((float*)(ws + WS_PEB))[768] = 64.f * gq * gk * C2 * 1.03f; }
    if (parts & 4) { bf16_t* sw = (bf16_t*)(ws + WS_SGUW);
      for (int e = gt; e < 8 * 128 * 128; e += NGT) { const int tt = (e >> 7) & 127, s = e & 127; const float w = (s <= tt) ? P.in[17][e] : 0.f; sw[e] = (bf16_t)(cvt_pk_bf16(w, 0.f) & 0xffffu); } }
    if (parts & 4) { const int gwv = C.blk * NWAVES + wave, NGWV = C.nblk * NWAVES;
      for (int it = gwv; it < 64; it += NGWV) { const int kv = it >> 5, kc = it & 31; const float* pe = P.in[23 + kv] + kc * 64; const float* w1 = P.in[25 + 2 * kv] + (size_t)(kc * 64) * 256; const unsigned lo4 = 4u * lane;
          f32x4 acc = {0.f, 0.f, 0.f, 0.f};
#pragma unroll 16
          for (int k = 0; k < 64; ++k) acc += *(const f32x4*)((w1 + (size_t)k * 256) + lo4) * pe[k];
          *(f32x4*)((float*)(ws + WS_PEB) + 1024 + (kv * 32 + kc) * 256 + 4 * lane) = acc; } }
    if (parts & 16) { const u32x4 z = {0u, 0u, 0u, 0u};
      for (int e = gt; e < 512 * 64 * 8; e += NGT) { *(u32x4*)((bf16_t*)(ws + WS_CKS) + (size_t)e * 8) = z; *(u32x4*)((bf16_t*)(ws + WS_CVS) + (size_t)e * 8) = z;
          *(u32x4*)((bf16_t*)(ws + WS_CWK) + (size_t)e * 8) = z; *(u32x4*)((bf16_t*)(ws + WS_CWV) + (size_t)e * 8) = z; }
      for (int e = gt; e < 1024; e += NGT) { *(u32x4*)((bf16_t*)(ws + WS_AK) + (size_t)NCROWS * 1024 + e * 8) = z; *(u32x4*)((bf16_t*)(ws + WS_AV) + (size_t)NCROWS * 1024 + e * 8) = z; } }
}


__device__ __forceinline__ void cache_convert(const Params& P, const Ctx& C) {
    unsigned char* ws = P.ws; LAUNDER_GPTR(ws); int lane_ = fresh_lane(); const int lane = lane_, wave = C.wave;
    { const int gwv = C.blk * NWAVES + wave, NGWV = C.nblk * NWAVES;
      for (int it = gwv; it < 2 * NSEQ * 16 * 4; it += NGWV) {
        const int qt = it & 3, sp = (it >> 2) & 2047, ci = it >> 13, seq = sp >> 4, pi = sp & 15;
        const int page = ((const int*)P.in[8])[seq * 16 + pi];
        const float* src = P.in[2 + ci] + (size_t)page * (128 * 256) + (size_t)qt * (32 * 256);
        bf16_t* dst = (bf16_t*)(ws + (ci ? WS_AV : WS_AK)) + 4194304;
        f32x4 a[16], c[16];
#pragma unroll
        for (int j = 0; j < 16; ++j) { const float* sj = src + (size_t)(64 * j) * 8; a[j] = *(const f32x4*)(sj + 8u * lane); c[j] = *(const f32x4*)(sj + 8u * lane + 4); }
#pragma unroll
        for (int j = 0; j < 16; ++j) { const int q = lane + 64 * j, posn = qt * 32 + (q >> 5), g = (q & 31) >> 3, d0 = (q & 7) * 8;
            u32x4 w; w.x = pk2(a[j][0], a[j][1]); w.y = pk2(a[j][2], a[j][3]); w.z = pk2(c[j][0], c[j][1]); w.w = pk2(c[j][2], c[j][3]);
            *(u32x4*)(dst + ((size_t)(seq * 4 + g) * TC + pi * 128 + posn) * 64 + d0) = w; }
      } }
    VM_WAIT();
    __syncthreads();
}

template <int WHICH> __device__ __forceinline__ void phase_modulate(const Params& P, const Ctx& C) {
    unsigned char* ws = P.ws; LAUNDER_GPTR(ws);
    const float* MOD = (const float*)(ws + WS_MOD);
    const float* gn = P.in[WHICH == 0 ? 13 : 14];
    bf16_t* H = (bf16_t*)(ws + WS_H);
    const int gw = C.blk * NWAVES + C.wave, NGW = C.nblk * NWAVES, lane = fresh_lane(), tid_c = C.wave * 64 + lane;
    if (WHICH == 0 && C.blk == 0) { float* peb = (float*)(ws + WS_PEB); float a = 0.f;
#pragma unroll
        for (int kc = 0; kc < 32; ++kc) a += peb[1024 + ((tid_c >> 8) * 32 + kc) * 256 + (tid_c & 255)];
        peb[tid_c] = a; }
    for (int r = gw; r < NR; r += NGW) {
        const float* xr = (WHICH == 0) ? (r < NPR ? P.in[0] + (size_t)r * DM : P.in[1] + (size_t)(r - NPR) * DM) : (const float*)(ws + WS_X1) + (size_t)r * DM;
        const float* mr = MOD + (size_t)pg8::mod_row(r) * 6144 + (WHICH == 0 ? 0 : 3072);
        f32x4 v[4]; float ss = 0.f;
#pragma unroll
        for (int j = 0; j < 4; ++j) { v[j] = *(const f32x4*)(xr + 4 * lane + 256 * j); ss += (v[j][0] * v[j][0] + v[j][1] * v[j][1]) + (v[j][2] * v[j][2] + v[j][3] * v[j][3]); }
        const float rstd = 1.0f / sqrtf(wave_sum(ss) * (1.f / DM) + EPS);
#pragma unroll
        for (int j = 0; j < 4; ++j) { const int c = 4 * lane + 256 * j;
            const f32x4 g = *(const f32x4*)(gn + c), sh = *(const f32x4*)(mr + c), sc = *(const f32x4*)(mr + 1024 + c);
            const f32x4 o = v[j] * rstd * g * (sc + 1.0f) + sh;
            u32x2 w; w.x = pk2(o[0], o[1]); w.y = pk2(o[2], o[3]);
            *(u32x2*)(H + (size_t)r * DM + c) = w; }
    }
}

#define F16Z_ {0.f, 0.f, 0.f, 0.f, 0.f, 0.f, 0.f, 0.f, 0.f, 0.f, 0.f, 0.f, 0.f, 0.f, 0.f, 0.f}
typedef short v4i16_t __attribute__((ext_vector_type(4)));
__device__ __forceinline__ s16x4 tr16(const LAS unsigned char* p) { return __builtin_bit_cast(s16x4, __builtin_amdgcn_ds_read_tr16_b64_v4i16((LAS v4i16_t*)p)); }
__device__ __forceinline__ bf16x8 cat8(s16x4 lo, s16x4 hi) { return (bf16x8){lo[0], lo[1], lo[2], lo[3], hi[0], hi[1], hi[2], hi[3]}; }

__device__ __forceinline__ void phase_chunk_mlp(const Params& P, const Ctx& C, int vb, int vn) {
    unsigned char* ws = P.ws; LAUNDER_GPTR(ws);
    const bf16_t* U = (const bf16_t*)(ws + WS_U); const bf16_t* V = (const bf16_t*)(ws + WS_V); bf16_t* MIX = (bf16_t*)(ws + WS_MIX);
    const bf16_t* SW = (const bf16_t*)(ws + WS_SGUW);
    int lane_ = fresh_lane();
    const int lane = lane_, wave = C.wave, tid = wave * 64 + lane, r32 = lane & 31, hi = lane >> 5;
    LAS unsigned char* vt = C.lds + wave * 16384;
    for (int un = vb * NWAVES + wave; un < 2 * 64 * 8; un += vn * NWAVES) {
        const int g = un & 7, ch = (un >> 3) & 63, b = un >> 9;
        const size_t row0 = (size_t)b * SEQ + ch * 128;
        LDS_WAIT();
        { u32x4 x[16]; const unsigned char* vsrc = (const unsigned char*)(V + (row0 + (lane >> 3)) * 512 + g * 64) + (lane & 7) * 16;
#pragma unroll
          for (int it = 0; it < 16; ++it) x[it] = *(const u32x4*)(vsrc + (size_t)(8 * it) * 1024);
#pragma unroll
          for (int it = 0; it < 16; ++it) *(LAS u32x4*)(vt + ((lane & 7) >> 2) * 8192 + (8 * it + (lane >> 3)) * 64 + (lane & 3) * 16) = x[it]; }
        LDS_WAIT();
        const LAS unsigned char* vb0 = vt + ((lane >> 4) & 1) * 32 + (lane & 3) * 8 + (8 * hi + ((lane & 15) >> 2)) * 64;
#pragma unroll
        for (int tb = 0; tb < 4; ++tb) {
            const int t = 32 * tb + r32;
            const bf16_t* wrow = SW + ((size_t)g * 128 + t) * 128 + 8 * hi;
            bf16x8 wf[8];
#pragma unroll
            for (int ks = 0; ks < 2 * tb + 2; ++ks) wf[ks] = *(const bf16x8*)(wrow + 16 * ks);
            const float bs = P.in[18][g * 128 + t];
            const size_t ro = row0 + t;
            u32x2 ug0[4], ug1[4];
#pragma unroll
            for (int rq = 0; rq < 4; ++rq) { const int d0 = 8 * rq + 4 * hi; ug0[rq] = *(const u32x2*)(U + ro * 512 + g * 64 + d0); ug1[rq] = *(const u32x2*)(U + ro * 512 + g * 64 + 32 + d0); }
            f32x16 acc0 = F16Z_, acc1 = F16Z_;
#pragma unroll
            for (int ks = 0; ks < 2 * tb + 2; ++ks) {
                const bf16x8 v0 = cat8(tr16(vb0 + ks * 1024), tr16(vb0 + ks * 1024 + 256));
                const bf16x8 v1 = cat8(tr16(vb0 + 8192 + ks * 1024), tr16(vb0 + 8192 + ks * 1024 + 256));
                acc0 = MFMA32(v0, wf[ks], acc0); acc1 = MFMA32(v1, wf[ks], acc1); }
#pragma unroll
            for (int rq = 0; rq < 4; ++rq) { const int d0 = 8 * rq + 4 * hi;
                const u32x2 u0 = ug0[rq], u1 = ug1[rq];
                u32x2 w; w.x = pk2(bflo(u0.x) * (acc0[4 * rq] + bs), bfhi(u0.x) * (acc0[4 * rq + 1] + bs)); w.y = pk2(bflo(u0.y) * (acc0[4 * rq + 2] + bs), bfhi(u0.y) * (acc0[4 * rq + 3] + bs));
                *(u32x2*)(MIX + ro * 1024 + g * 64 + d0) = w;
                w.x = pk2(bflo(u1.x) * (acc1[4 * rq] + bs), bfhi(u1.x) * (acc1[4 * rq + 1] + bs)); w.y = pk2(bflo(u1.y) * (acc1[4 * rq + 2] + bs), bfhi(u1.y) * (acc1[4 * rq + 3] + bs));
                *(u32x2*)(MIX + ro * 1024 + g * 64 + 32 + d0) = w; }
        }
    }
    const int gt = vb * 512 + tid, NGT = vn * 512;
    for (int e = gt; e < NSEQ * 4 * 512; e += NGT) { const int col = e & 511, tt = (e >> 9) & 3, seq = e >> 11, g = col >> 6;
        float a = P.in[18][g * 128 + tt];
        for (int s = 0; s <= tt; ++s) a += P.in[17][(g * 128 + tt) * 128 + s] * bf2f(V[((size_t)NPR + seq * 4 + s) * 512 + col]);
        const size_t r = (size_t)NPR + seq * 4 + tt;
        MIX[r * 1024 + col] = (bf16_t)(pk2(bf2f(U[r * 512 + col]) * a, 0.f) & 0xffffu); }
}

__device__ __forceinline__ void phase_cmp2(const Params& P, const Ctx& C) {
    unsigned char* ws = P.ws; LAUNDER_GPTR(ws);
    const int lane = fresh_lane(), r32 = lane & 31, hi = lane >> 5;
    const int gw = C.blk * NWAVES + C.wave, NGW = C.nblk * NWAVES;
    constexpr int NI = NCROWS / 32;
    for (int it = gw; it < 2 * NI; it += NGW) {
        const int kv = it >= NI, row0 = (kv ? it - NI : it) * 32;
        const bf16_t* HID = (const bf16_t*)(ws + (kv ? WS_HIDV : WS_HIDK)) + (size_t)(row0 + r32) * 256 + 8 * hi;
        const bf16_t* W2T = (const bf16_t*)(ws + (kv ? WS_W2TV : WS_W2TK)) + (size_t)r32 * 256 + 8 * hi;
        f32x16 a0 = F16Z_, a1 = a0;
#pragma unroll 4
        for (int ks = 0; ks < 16; ++ks) { const bf16x8 hf = *(const bf16x8*)(HID + 16 * ks);
            a0 = MFMA32(*(const bf16x8*)(W2T + 16 * ks), hf, a0); a1 = MFMA32(*(const bf16x8*)(W2T + 32 * 256 + 16 * ks), hf, a1); }
        bf16_t* O = (bf16_t*)(ws + (kv ? WS_VCC : WS_KCC)) + (size_t)(row0 + r32) * 64;
#pragma unroll
        for (int rq = 0; rq < 4; ++rq) { u32x2 w;
            w.x = pk2(a0[4 * rq], a0[4 * rq + 1]); w.y = pk2(a0[4 * rq + 2], a0[4 * rq + 3]); *(u32x2*)(O + 8 * rq + 4 * hi) = w;
            w.x = pk2(a1[4 * rq], a1[4 * rq + 1]); w.y = pk2(a1[4 * rq + 2], a1[4 * rq + 3]); *(u32x2*)(O + 32 + 8 * rq + 4 * hi) = w; }
    }
}

__device__ __forceinline__ void cmp2_tile(const Params& P, const Ctx& C, int kv, int pm) {
    unsigned char* ws = P.ws; LAUNDER_GPTR(ws);
    const int lane = fresh_lane(), r32 = lane & 31, hi = lane >> 5;
    const int row0 = pm * 256 + 32 * C.wave;
    const bf16_t* HID = (const bf16_t*)(ws + (kv ? WS_HIDV : WS_HIDK)) + (size_t)(row0 + r32) * 256 + 8 * hi;
    const bf16_t* W2T = (const bf16_t*)(ws + (kv ? WS_W2TV : WS_W2TK)) + (size_t)r32 * 256 + 8 * hi;
    f32x16 a0 = F16Z_, a1 = a0;
#pragma unroll 8
    for (int ks = 0; ks < 16; ++ks) { const bf16x8 hf = *(const bf16x8*)(HID + 16 * ks);
        a0 = MFMA32(*(const bf16x8*)(W2T + 16 * ks), hf, a0); a1 = MFMA32(*(const bf16x8*)(W2T + 32 * 256 + 16 * ks), hf, a1); }
    bf16_t* O = (bf16_t*)(ws + (kv ? WS_VCC : WS_KCC)) + (size_t)(row0 + r32) * 64;
#pragma unroll
    for (int rq = 0; rq < 4; ++rq) { u32x2 w;
        w.x = pk2(a0[4 * rq], a0[4 * rq + 1]); w.y = pk2(a0[4 * rq + 2], a0[4 * rq + 3]); *(u32x2*)(O + 8 * rq + 4 * hi) = w;
        w.x = pk2(a1[4 * rq], a1[4 * rq + 1]); w.y = pk2(a1[4 * rq + 2], a1[4 * rq + 3]); *(u32x2*)(O + 32 + 8 * rq + 4 * hi) = w; }
}

template <int WHICH> __device__ __forceinline__ void sample_rows_gemm(const Params& P, const Ctx& C) {
    unsigned char* ws = P.ws; LAUNDER_GPTR(ws);
    constexpr int K = (WHICH == 0) ? DM : DFF, KE = K / 8;
    const bf16_t* ACT = (const bf16_t*)(ws + (WHICH == 0 ? WS_MIX : WS_F)); const bf16_t* WT = (const bf16_t*)(ws + (WHICH == 0 ? WS_WTOUT : WS_WTF2));
    int lane_ = fresh_lane();
    const int lane = lane_, wave = C.wave, r32 = lane & 31, hi = lane >> 5;
    LAS float* R = (LAS float*)C.lds;
    for (int pc = C.blk; pc < 256; pc += C.nblk) {
        const int rb = pc >> 4, cb = pc & 15;
        const int m = NPR + rb * 32 + r32;
        const bf16_t* wp = WT + (size_t)(cb * 64 + r32) * K + wave * KE + 8 * hi; const bf16_t* ap = ACT + (size_t)m * K + wave * KE + 8 * hi;
        f32x16 acc0 = F16Z_, acc1 = F16Z_;
#pragma unroll (WHICH == 0 ? 8 : 11)
        for (int ks = 0; ks < KE / 16; ++ks) { const bf16x8 af = *(const bf16x8*)(ap + 16 * ks);
            acc0 = MFMA32(*(const bf16x8*)(wp + 16 * ks), af, acc0); acc1 = MFMA32(*(const bf16x8*)(wp + (size_t)32 * K + 16 * ks), af, acc1); }
        __syncthreads();
#pragma unroll
        for (int r = 0; r < 16; ++r) { R[((wave * 2 + 0) * 16 + r) * 64 + lane] = acc0[r]; R[((wave * 2 + 1) * 16 + r) * 64 + lane] = acc1[r]; }
        __syncthreads();
        if (wave < 2) { const int nb = wave; f32x16 acc;
#pragma unroll
            for (int r = 0; r < 16; ++r) { float s = R[((0 * 2 + nb) * 16 + r) * 64 + lane];
#pragma unroll
                for (int w8 = 1; w8 < 8; ++w8) s += R[((w8 * 2 + nb) * 16 + r) * 64 + lane];
                acc[r] = s; }
            const float* MOD = (const float*)(ws + WS_MOD) + (size_t)pg8::mod_row(m) * 6144 + (WHICH == 0 ? 2048 : 5120);
            const float* res = (WHICH == 0) ? P.in[1] + (size_t)(m - NPR) * DM : (const float*)(ws + WS_X1) + (size_t)m * DM;
            float* dst = (WHICH == 0) ? (float*)(ws + WS_X1) + (size_t)m * DM : P.out + (size_t)m * DM;
#pragma unroll
            for (int rq = 0; rq < 4; ++rq) { const int c0 = cb * 64 + nb * 32 + 8 * rq + 4 * hi;
                const f32x4 a = {acc[4 * rq], acc[4 * rq + 1], acc[4 * rq + 2], acc[4 * rq + 3]};
                *(f32x4*)(dst + c0) = *(const f32x4*)(res + c0) + *(const f32x4*)(MOD + c0) * a; }
        }
    }
    __syncthreads();
}
#define F16Z {0.f, 0.f, 0.f, 0.f, 0.f, 0.f, 0.f, 0.f, 0.f, 0.f, 0.f, 0.f, 0.f, 0.f, 0.f, 0.f}
constexpr float NEG_INF = -__builtin_inff();

__device__ __forceinline__ void qk_tile_sw(const LAS unsigned char* kb, const bf16x8 (&qr)[4], f32x16& s0, f32x16& s1, int r32, int hi) {
    f32x16 a = {0.f, 0.f, 0.f, 0.f, 0.f, 0.f, 0.f, 0.f, 0.f, 0.f, 0.f, 0.f, 0.f, 0.f, 0.f, 0.f}, b = a;
    const LAS unsigned char* kp = kb + hi * 1024 + (r32 & ~7) * 16;
#pragma unroll
    for (int d0 = 0; d0 < 4; ++d0) { const int lo = (r32 + 2 * d0 + hi) & 7;
        const bf16x8 k0 = *(const LAS bf16x8*)(kp + d0 * 2048 + lo * 16), k1 = *(const LAS bf16x8*)(kp + d0 * 2048 + lo * 16 + 512);
        a = MFMA32(k0, qr[d0], a); b = MFMA32(k1, qr[d0], b);
    }
    s0 = a; s1 = b;
}
__device__ __forceinline__ void qk_tile(const LAS unsigned char* kb, const bf16x8 (&qr)[4], f32x16& s0, f32x16& s1, int r32, int hi) {
    const LAS unsigned char* kp = kb + hi * 1024 + r32 * 16;
    f32x16 a = F16Z, b = F16Z;
#pragma unroll
    for (int d0 = 0; d0 < 4; ++d0) {
        const bf16x8 k0 = *(const LAS bf16x8*)(kp + d0 * 2048), k1 = *(const LAS bf16x8*)(kp + d0 * 2048 + 512);
        a = MFMA32(k0, qr[d0], a); b = MFMA32(k1, qr[d0], b);
    }
    s0 = a; s1 = b;
}
__device__ __forceinline__ void mask_tile(f32x16& s0, f32x16& s1, int key0, int klo, int khi, bool en, int hi) {
#pragma unroll
    for (int r = 0; r < 16; ++r) { const int k = key0 + crow(r, hi);
        if (!(en && k >= klo && k <= khi)) s0[r] = NEG_INF;
        if (!(en && k + 32 >= klo && k + 32 <= khi)) s1[r] = NEG_INF; }
}
__device__ __forceinline__ float half_swap_max(float m) { auto rr = __builtin_amdgcn_permlane32_swap(__float_as_uint(m), __float_as_uint(m), false, false); return fmaxf(__uint_as_float(rr[0]), __uint_as_float(rr[1])); }
__device__ __forceinline__ float half_swap_sum(float m) { auto rr = __builtin_amdgcn_permlane32_swap(__float_as_uint(m), __float_as_uint(m), false, false); return __uint_as_float(rr[0]) + __uint_as_float(rr[1]); }
__device__ __forceinline__ float tile_max(const f32x16& s0, const f32x16& s1) {
    float m = fmaxf(s0[0], s1[0]);
#pragma unroll
    for (int r = 1; r < 16; ++r) m = fmaxf(m, fmaxf(s0[r], s1[r]));
    return half_swap_max(m);
}
__device__ __forceinline__ void stats_step(const f32x16& s0, const f32x16& s1, float& m_run, float& l_run) {
    const float mn = fmaxf(m_run, tile_max(s0, s1)); const float alpha = fast_exp2(m_run - mn); m_run = mn;
    float sum = 0.f;
#pragma unroll
    for (int r = 0; r < 16; ++r) sum += fast_exp2(s0[r] - mn) + fast_exp2(s1[r] - mn);
    l_run = l_run * alpha + sum;
}
__device__ __forceinline__ void softmax_step(f32x16& s0, f32x16& s1, float& m_run, float& l_run, f32x16& o0, f32x16& o1) {
    const float mn = fmaxf(m_run, tile_max(s0, s1)); const float alpha = fast_exp2(m_run - mn); m_run = mn;
    float sum = 0.f;
#pragma unroll
    for (int r = 0; r < 16; ++r) { s0[r] = fast_exp2(s0[r] - mn); s1[r] = fast_exp2(s1[r] - mn); sum += s0[r] + s1[r]; }
    l_run = l_run * alpha + sum;
    o0 = o0 * alpha; o1 = o1 * alpha;
}
__device__ __forceinline__ bf16x8 pack8(const f32x16& p, int o) {
    u32x4 w; w.x = cvt_pk_bf16(p[o], p[o + 1]); w.y = cvt_pk_bf16(p[o + 2], p[o + 3]); w.z = cvt_pk_bf16(p[o + 4], p[o + 5]); w.w = cvt_pk_bf16(p[o + 6], p[o + 7]);
    return __builtin_bit_cast(bf16x8, w);
}
__device__ __forceinline__ void pv_tile(const LAS unsigned char* vb, const f32x16& p0, const f32x16& p1, f32x16& o0, f32x16& o1, int lane, int hi) {
    const LAS unsigned char* vp = vb + ((lane >> 4) & 1) * 32 + (lane & 3) * 8 + (4 * hi + ((lane & 15) >> 2)) * 64;
#pragma unroll
    for (int kk = 0; kk < 4; ++kk) {
        const bf16x8 pf = (kk < 2) ? pack8(p0, 8 * kk) : pack8(p1, 8 * (kk - 2));
        const bf16x8 v0 = cat8(tr16(vp + kk * 1024), tr16(vp + kk * 1024 + 512));
        const bf16x8 v1 = cat8(tr16(vp + 4096 + kk * 1024), tr16(vp + 4096 + kk * 1024 + 512));
        o0 = MFMA32(v0, pf, o0); o1 = MFMA32(v1, pf, o1);
    }
}
__device__ __forceinline__ void tile_ld(const bf16_t* kt, const bf16_t* vt, int wave, int lane, u32x4& kr, u32x4& vr) {
    kr = *(const u32x4*)((const unsigned char*)kt + lane * 128 + wave * 16);
    vr = *(const u32x4*)((const unsigned char*)vt + (16 * (wave & 3) + (lane >> 2)) * 128 + (wave >> 2) * 64 + (lane & 3) * 16);
}
__device__ __forceinline__ void tile_st(LAS unsigned char* kb, LAS unsigned char* vb, int wave, int lane, const u32x4& kr, const u32x4& vr) {
    *(LAS u32x4*)(kb + wave * 1024 + lane * 16) = kr; *(LAS u32x4*)(vb + wave * 1024 + lane * 16) = vr;
}
__device__ __forceinline__ void wave_tile_load(const bf16_t* kt, const bf16_t* vt, LAS unsigned char* kb, LAS unsigned char* vb, int lane) {
    LDS_WAIT();
    { u32x4 kr[8];
#pragma unroll
      for (int c = 0; c < 8; ++c) kr[c] = *(const u32x4*)((const unsigned char*)kt + lane * 128 + c * 16);
#pragma unroll
      for (int c = 0; c < 8; ++c) *(LAS u32x4*)(kb + c * 1024 + lane * 16) = kr[c]; }
    __builtin_amdgcn_sched_barrier(0);
    { u32x4 vr[8];
#pragma unroll
      for (int c = 0; c < 8; ++c) vr[c] = *(const u32x4*)((const unsigned char*)vt + (16 * (c & 3) + (lane >> 2)) * 128 + (c >> 2) * 64 + (lane & 3) * 16);
#pragma unroll
      for (int c = 0; c < 8; ++c) *(LAS u32x4*)(vb + c * 1024 + lane * 16) = vr[c]; }
    LDS_WAIT();
}
__device__ __forceinline__ void wave_tile_issue(const bf16_t* kt, const bf16_t* vt, int lane, u32x4 (&kr)[8], u32x4 (&vr)[8]) {
#pragma unroll
    for (int c = 0; c < 8; ++c) kr[c] = *(const u32x4*)((const unsigned char*)kt + lane * 128 + c * 16);
#pragma unroll
    for (int c = 0; c < 8; ++c) vr[c] = *(const u32x4*)((const unsigned char*)vt + (16 * (c & 3) + (lane >> 2)) * 128 + (c >> 2) * 64 + (lane & 3) * 16);
}
__device__ __forceinline__ void wave_tile_commit(const u32x4 (&kr)[8], const u32x4 (&vr)[8], LAS unsigned char* kb, LAS unsigned char* vb, int lane) {
    LDS_WAIT();
#pragma unroll
    for (int c = 0; c < 8; ++c) *(LAS u32x4*)(kb + c * 1024 + lane * 16) = kr[c];
#pragma unroll
    for (int c = 0; c < 8; ++c) *(LAS u32x4*)(vb + c * 1024 + lane * 16) = vr[c];
    LDS_WAIT();
}
__device__ __forceinline__ void imp_tile(const f32x16& p0, const f32x16& p1, int hi, float& carry, float (&val)[8]) {
    float P4[8], X[8];
#pragma unroll
    for (int gi = 0; gi < 8; ++gi) { const int k = (gi & 3) * 4;
        const float a0 = (gi < 4) ? p0[k] : p1[k], a1 = (gi < 4) ? p0[k + 1] : p1[k + 1], a2 = (gi < 4) ? p0[k + 2] : p1[k + 2], a3 = (gi < 4) ? p0[k + 3] : p1[k + 3];
        P4[gi] = (a0 + a1) + (a2 + a3); X[gi] = __shfl_xor(a3, 32); }
#pragma unroll
    for (int gi = 0; gi < 8; ++gi) val[gi] = P4[gi] + (hi ? X[gi] : (gi == 0 ? carry : X[gi > 0 ? gi - 1 : 0]));
    carry = X[7];
}
__device__ __forceinline__ unsigned topk_select(const LAS float* imp, int cur, int sub) {
    unsigned mask = 0u;
    if (cur <= 15) { if (sub == 0) mask = (2u << cur) - 1u; return mask; }
    unsigned key[32];
    { const LAS float* base = imp + 32 * sub; const int lo = 1 - 32 * sub, hi_ = cur - 2 - 32 * sub;
#pragma unroll
      for (int k = 0; k < 8; ++k) { const f32x4 q = *(const LAS f32x4*)(base + 4 * k);
#pragma unroll
          for (int e = 0; e < 4; ++e) { const int i = 4 * k + e; const unsigned kb = ((__float_as_uint(q[e]) << 1) & 0xffffff80u) | (unsigned)(127 - (32 * sub + i));
              key[i] = (i >= lo && i <= hi_) ? kb : 0u; } } }
    unsigned prev = 0xffffffffu;
    for (int it = 0; it < 13; ++it) {
        const unsigned c = prev - 1u; unsigned g = c - key[0];
#pragma unroll
        for (int i = 1; i < 32; ++i) { const unsigned d = c - key[i]; g = d < g ? d : g; }
#pragma unroll
        for (int off = 1; off <= 2; off <<= 1) { const unsigned og = (unsigned)__shfl_xor((int)g, off); g = og < g ? og : g; }
        prev = c - g;
    }
#pragma unroll
    for (int i = 31; i >= 0; --i) mask = (mask << 1) | ((key[i] >= prev) ? 1u : 0u);
    if (sub == 0) mask |= 1u;
    if (((cur - 1) >> 5) == sub) mask |= 1u << ((cur - 1) & 31);
    if ((cur >> 5) == sub) mask |= 1u << (cur & 31);
    return mask;
}
__device__ __forceinline__ unsigned sel_word(const unsigned (&w)[4], int j) { const int k = j >> 5; return (k == 0) ? w[0] : (k == 1) ? w[1] : (k == 2) ? w[2] : w[3]; }

constexpr float ATT_THR = 8.f;
__device__ __forceinline__ void pv_tile_m(const LAS unsigned char* vb, const f32x16& p0, const f32x16& p1, f32x16& o0, f32x16& o1, int lane, int hi, unsigned enm) {
    const LAS unsigned char* vp = vb + ((lane >> 4) & 1) * 32 + (lane & 3) * 8 + (4 * hi + ((lane & 15) >> 2)) * 64;
#pragma unroll
    for (int kk = 0; kk < 4; ++kk) {
        u32x4 w = __builtin_bit_cast(u32x4, (kk < 2) ? pack8(p0, 8 * kk) : pack8(p1, 8 * (kk - 2)));
        w.x &= enm; w.y &= enm; w.z &= enm; w.w &= enm;
        const bf16x8 pf = __builtin_bit_cast(bf16x8, w);
        const bf16x8 v0 = cat8(tr16(vp + kk * 1024), tr16(vp + kk * 1024 + 512));
        const bf16x8 v1 = cat8(tr16(vp + 4096 + kk * 1024), tr16(vp + 4096 + kk * 1024 + 512));
        o0 = MFMA32(v0, pf, o0); o1 = MFMA32(v1, pf, o1);
    }
}
template <bool EMASK, bool DO_PV>
__device__ __forceinline__ void att_step(const LAS unsigned char* kb, const LAS unsigned char* vb, const bf16x8 (&qr)[4], float& m, float& l, f32x16& nm, f32x16& o0, f32x16& o1,
                                         f32x16& a, f32x16& b, int key0, int klo, int khi, bool en, int lane, int r32, int hi) {
    const LAS unsigned char* kp = kb + hi * 1024 + r32 * 16;
    a = nm; b = nm;
#pragma unroll
    for (int d0 = 0; d0 < 4; ++d0) {
        const bf16x8 k0 = *(const LAS bf16x8*)(kp + d0 * 2048), k1 = *(const LAS bf16x8*)(kp + d0 * 2048 + 512);
        a = MFMA32(k0, qr[d0], a); b = MFMA32(k1, qr[d0], b);
    }
    if (EMASK) mask_tile(a, b, key0, klo, khi, true, hi);
    float mx = tile_max(a, b); mx = en ? mx : NEG_INF;
    const bool unset = m < -1e29f;
    const bool need = unset ? (mx > NEG_INF) : (mx > ATT_THR);
    if (__any(need)) {
        const float d = unset ? (need ? mx : 0.f) : fmaxf(mx, 0.f);
        const float al = unset ? 1.f : fast_exp2(-d);
        m = unset ? (need ? mx : m) : m + d;
        l *= al; if (DO_PV) { o0 = o0 * al; o1 = o1 * al; }
        nm = nm - d; a = a - d; b = b - d;
    }
    float sum = 0.f;
#pragma unroll
    for (int r = 0; r < 16; ++r) { a[r] = fast_exp2(a[r]); b[r] = fast_exp2(b[r]); sum += a[r] + b[r]; }
    l += en ? sum : 0.f;
    if (DO_PV) pv_tile_m(vb, a, b, o0, o1, lane, hi, en ? 0xffffffffu : 0u);
}

typedef __bf16 bf16x2_t __attribute__((ext_vector_type(2)));
__device__ __forceinline__ float bfsum2(unsigned w, float c) { return __builtin_amdgcn_fdot2_f32_bf16(__builtin_bit_cast(bf16x2_t, w), __builtin_bit_cast(bf16x2_t, 0x3f803f80u), c, false); }
template <bool EMASK, bool FIXED, bool ENPERM = false>
__device__ __forceinline__ void att_qk_sm(const LAS unsigned char* kb, const bf16x8 (&qr)[4], float& m, float& l, f32x16& nm, f32x16& o0, f32x16& o1,
                                          u32x4 (&pw)[4], int key0, int klo, int khi, bool en, int r32, int hi, const LAS unsigned char* vb, int lane, bf16x8 (&v0)[4], bf16x8 (&v1)[4]) {
    const LAS unsigned char* kp = kb + hi * 1024 + r32 * 16;
    f32x16 a, b;
    if (FIXED) { a = (f32x16)F16Z; b = (f32x16)F16Z; } else { a = nm; b = nm; }
    bf16x8 kf[8];
#pragma unroll
    for (int d0 = 0; d0 < 4; ++d0) { kf[2 * d0] = *(const LAS bf16x8*)(kp + d0 * 2048); kf[2 * d0 + 1] = *(const LAS bf16x8*)(kp + d0 * 2048 + 512); }
    if (FIXED) { const LAS unsigned char* vp = vb + ((lane >> 4) & 1) * 32 + (lane & 3) * 8 + (4 * hi + ((lane & 15) >> 2)) * 64;
#pragma unroll
      for (int kk = 0; kk < 4; ++kk) { v0[kk] = cat8(tr16(vp + kk * 1024), tr16(vp + kk * 1024 + 512)); v1[kk] = cat8(tr16(vp + 4096 + kk * 1024), tr16(vp + 4096 + kk * 1024 + 512)); } }
    __builtin_amdgcn_s_setprio(1);
#pragma unroll
    for (int d0 = 0; d0 < 4; ++d0) { a = MFMA32(kf[2 * d0], qr[d0], a); b = MFMA32(kf[2 * d0 + 1], qr[d0], b); }
    __builtin_amdgcn_s_setprio(0);
    if (EMASK) mask_tile(a, b, key0, klo, khi, true, hi);
    if (!FIXED) {
        float mx = tile_max(a, b); mx = en ? mx : NEG_INF;
        const bool unset = m < -1e29f;
        const bool need = unset ? (mx > NEG_INF) : (mx > ATT_THR);
        if (__any(need)) {
            const float d = unset ? (need ? mx : 0.f) : fmaxf(mx, 0.f);
            const float al = unset ? 1.f : fast_exp2(-d);
            m = unset ? (need ? mx : m) : m + d;
            l *= al; o0 = o0 * al; o1 = o1 * al;
            nm = nm - d; a = a - d; b = b - d;
        }
    }
#pragma unroll
    for (int r = 0; r < 16; ++r) { a[r] = fast_exp2(a[r]); b[r] = fast_exp2(b[r]); }
    if (FIXED && ENPERM) { unsigned enm_ = en ? 0xffffffffu : 0u; asm volatile("" : "+v"(enm_));
        const unsigned sel = 0x0c0c0c0cu - (enm_ & 0x0506090au);
#pragma unroll
        for (int kk = 0; kk < 4; ++kk)
#pragma unroll
            for (int p = 0; p < 4; ++p) { const int e = 8 * (kk & 1) + 2 * p; const float x0 = (kk < 2) ? a[e] : b[e], x1 = (kk < 2) ? a[e + 1] : b[e + 1];
                pw[kk][p] = __builtin_amdgcn_perm(__float_as_uint(x1), __float_as_uint(x0), sel); }
        return; }
    const unsigned enm = en ? 0xffffffffu : 0u; float sum = 0.f;
#pragma unroll
    for (int kk = 0; kk < 4; ++kk) { u32x4 w = __builtin_bit_cast(u32x4, (kk < 2) ? pack8(a, 8 * kk) : pack8(b, 8 * (kk - 2)));
        w.x &= enm; w.y &= enm; w.z &= enm; w.w &= enm; pw[kk] = w;
        if (!FIXED) { sum = bfsum2(w.x, sum); sum = bfsum2(w.y, sum); sum = bfsum2(w.z, sum); sum = bfsum2(w.w, sum); } }
    if (!FIXED) l += sum;
}
template <bool LSUM>
__device__ __forceinline__ void pv_packed(const LAS unsigned char* vb, int lane, int hi, bf16x8 (&v0)[4], bf16x8 (&v1)[4], const u32x4 (&pw)[4], f32x16& o0, f32x16& o1, f32x4& lacc, const bf16x8& onesA) {
    if (!LSUM) { const LAS unsigned char* vp = vb + ((lane >> 4) & 1) * 32 + (lane & 3) * 8 + (4 * hi + ((lane & 15) >> 2)) * 64;
#pragma unroll
      for (int kk = 0; kk < 4; ++kk) { v0[kk] = cat8(tr16(vp + kk * 1024), tr16(vp + kk * 1024 + 512)); v1[kk] = cat8(tr16(vp + 4096 + kk * 1024), tr16(vp + 4096 + kk * 1024 + 512)); } }
    __builtin_amdgcn_s_setprio(1);
#pragma unroll
    for (int kk = 0; kk < 4; ++kk) { const bf16x8 pf = __builtin_bit_cast(bf16x8, pw[kk]); o0 = MFMA32(v0[kk], pf, o0); o1 = MFMA32(v1[kk], pf, o1);
        if (LSUM) lacc = __builtin_amdgcn_mfma_f32_16x16x32_bf16(onesA, pf, lacc, 0, 0, 0); }
    __builtin_amdgcn_s_setprio(0);
}

constexpr int AT_KB = 0, AT_VB = 32768, AT_IMP = 65536, AT_SEL = 132096;
constexpr int DC_ML = 132096, DC_IMP = 140288, DC_SEL = 141312, DC_OC = 141824;

template <bool FIXED> __device__ __forceinline__ void attn_prompt_unit(const Params& P, const Ctx& C, int bg, int qb) {
    unsigned char* ws = P.ws; LAUNDER_GPTR(ws);
    int lane_ = fresh_lane();
    const int lane = lane_, wave = C.wave, r32 = lane & 31, hi = lane >> 5;
    const int b = bg >> 2, g = bg & 3, qi = r32 & 15, hsel = r32 >> 4, hq = 2 * g + hsel;
    const int t = 128 * qb + 16 * wave + qi;
    const size_t row = (size_t)b * SEQ + t;
    bf16x8 qr[4];
    { const bf16_t* qp = (const bf16_t*)(ws + WS_Q) + row * 512 + hq * 64 + hi * 8;
#pragma unroll
      for (int d0 = 0; d0 < 4; ++d0) qr[d0] = *(const bf16x8*)(qp + d0 * 16); }
    LAS unsigned char* KB = C.lds + AT_KB; LAS unsigned char* VB = C.lds + AT_VB;
    LAS float* IMP = (LAS float*)(C.lds + AT_IMP) + wave * 2048; LAS unsigned* SELM = (LAS unsigned*)(C.lds + AT_SEL) + wave * 64;
    const float* gts = (const float*)(ws + WS_GATES) + row * 24 + hq * 3;
    const float g0 = gts[0], g1 = gts[1], g2 = gts[2];
    f32x16 oa0, oa1, s0, s1;
    u32x4 kr, vr, kr2, vr2;
    const int t0 = 128 * qb + 16 * wave;
    f32x16 nm;
    {
        const int ntc = (qb >> 3) + 1, cmax = (t >= 31) ? ((t - 31) >> 4) : -1, cmin_w = (t0 >= 31) ? ((t0 - 31) >> 4) : -1;
        const bf16_t* kcb = (const bf16_t*)(ws + WS_KCC) + (size_t)bg * 512 * 64; const bf16_t* vcb = (const bf16_t*)(ws + WS_VCC) + (size_t)bg * 512 * 64;
        float m_c = -1e30f, l_c = 0.f; nm = (f32x16)F16Z;
        __syncthreads();
        tile_ld(kcb, vcb, wave, lane, kr, vr);
        for (int j = 0; j < ntc; ++j) {
            tile_st(KB + (j & 1) * 8192, VB + (j & 1) * 8192, wave, lane, kr, vr);
            __syncthreads();
            if (j + 1 < ntc) tile_ld(kcb + (size_t)(j + 1) * 4096, vcb + (size_t)(j + 1) * 4096, wave, lane, kr, vr);
            else tile_ld(kcb, vcb, wave, lane, kr, vr);
            if (64 * j + 63 <= cmin_w) att_step<false, false>(KB + (j & 1) * 8192, VB, qr, m_c, l_c, nm, s0, s1, s0, s1, 64 * j, 0, cmax, true, lane, r32, hi);
            else att_step<true, false>(KB + (j & 1) * 8192, VB, qr, m_c, l_c, nm, s0, s1, s0, s1, 64 * j, 0, cmax, true, lane, r32, hi);
        }
        nm = nm - __builtin_amdgcn_logf(fmaxf(half_swap_sum(l_c), 1e-20f));
        f32x16 oc0 = F16Z, oc1 = F16Z; float carry = 0.f;
        __syncthreads();
        for (int j = 0; j < ntc; ++j) {
            tile_st(KB + (j & 1) * 8192, VB + (j & 1) * 8192, wave, lane, kr, vr);
            __syncthreads();
            if (j + 1 < ntc) tile_ld(kcb + (size_t)(j + 1) * 4096, vcb + (size_t)(j + 1) * 4096, wave, lane, kr, vr);
            else { const bf16_t* ks_ = (const bf16_t*)(ws + WS_KS) + (size_t)bg * SEQ * 64; const bf16_t* vs_ = (const bf16_t*)(ws + WS_VS) + (size_t)bg * SEQ * 64;
                   tile_ld(ks_, vs_, wave, lane, kr, vr); tile_ld(ks_ + 4096, vs_ + 4096, wave, lane, kr2, vr2); }
            { const LAS unsigned char* kp = KB + (j & 1) * 8192 + hi * 1024 + r32 * 16; s0 = nm; s1 = nm;
#pragma unroll
              for (int d0 = 0; d0 < 4; ++d0) { const bf16x8 k0 = *(const LAS bf16x8*)(kp + d0 * 2048), k1 = *(const LAS bf16x8*)(kp + d0 * 2048 + 512);
                  s0 = MFMA32(k0, qr[d0], s0); s1 = MFMA32(k1, qr[d0], s1); } }
            if (64 * j + 63 > cmin_w) mask_tile(s0, s1, 64 * j, 0, cmax, true, hi);
#pragma unroll
            for (int r = 0; r < 16; ++r) { s0[r] = fast_exp2(s0[r]); s1[r] = fast_exp2(s1[r]); }
            float val[8]; imp_tile(s0, s1, hi, carry, val);
#pragma unroll
            for (int gi = 0; gi < 8; ++gi) val[gi] += __shfl_xor(val[gi], 16);
            if (hsel == 0) {
#pragma unroll
                for (int gi = 0; gi < 8; ++gi) IMP[qi * 128 + 16 * j + 2 * gi + hi] = val[gi]; }
            pv_tile(VB + (j & 1) * 8192, s0, s1, oc0, oc1, lane, hi);
        }
        LDS_WAIT();
        { const int tq = lane >> 2, sub = lane & 3, cur = (128 * qb + 16 * wave + tq) >> 6;
          const unsigned m = topk_select(IMP + tq * 128, cur, sub);
          SELM[tq * 4 + sub] = m; }
        LDS_WAIT();
#pragma unroll
        for (int r = 0; r < 16; ++r) { IMP[r * 64 + lane] = oc0[r] * g0; IMP[(16 + r) * 64 + lane] = oc1[r] * g0; }
    }
    unsigned selw[4];
#pragma unroll
    for (int k = 0; k < 4; ++k) selw[k] = SELM[qi * 4 + k];
    const unsigned one2 = ((lane & 15) == ((lane >> 4) & 1)) ? 0x3f803f80u : 0u;
    const bf16x8 onesA = __builtin_bit_cast(bf16x8, (u32x4){one2, one2, one2, one2});
    {
        const bf16_t* kb_ = (const bf16_t*)(ws + WS_KS) + (size_t)bg * SEQ * 64; const bf16_t* vb_ = (const bf16_t*)(ws + WS_VS) + (size_t)bg * SEQ * 64;
        const int jl = 2 * qb + 1, cur_w = t0 >> 6;
        float m_s = -1e30f, l_s = 0.f; f32x16 o0 = F16Z, o1 = F16Z; nm = (f32x16)F16Z; f32x4 lacc = {0.f, 0.f, 0.f, 0.f};
        u32x4 pw[4];
        __syncthreads();
        for (int jp = 0; jp <= jl; jp += 2) {
            LAS unsigned char* kcur = KB + ((jp >> 1) & 1) * 16384; LAS unsigned char* vcur = VB + ((jp >> 1) & 1) * 16384;
            tile_st(kcur, vcur, wave, lane, kr, vr); tile_st(kcur + 8192, vcur + 8192, wave, lane, kr2, vr2);
            __syncthreads();
            if (jp + 2 <= jl) { tile_ld(kb_ + (size_t)(jp + 2) * 4096, vb_ + (size_t)(jp + 2) * 4096, wave, lane, kr, vr); tile_ld(kb_ + (size_t)(jp + 3) * 4096, vb_ + (size_t)(jp + 3) * 4096, wave, lane, kr2, vr2); }
            else { const int jw_ = (2 * qb - 8 > 0) ? 2 * qb - 8 : 0; const bf16_t* kw_ = (const bf16_t*)(ws + WS_KW) + (size_t)bg * SEQ * 64; const bf16_t* vw_ = (const bf16_t*)(ws + WS_VW) + (size_t)bg * SEQ * 64;
                   tile_ld(kw_ + (size_t)jw_ * 4096, vw_ + (size_t)jw_ * 4096, wave, lane, kr, vr); tile_ld(kw_ + (size_t)(jw_ + 1) * 4096, vw_ + (size_t)(jw_ + 1) * 4096, wave, lane, kr2, vr2); }
#pragma unroll
            for (int h2 = 0; h2 < 2; ++h2) { const int j = jp + h2;
                const bool en = (sel_word(selw, j) >> (j & 31)) & 1u;
                const bool act = (j < cur_w) ? (bool)__any(en) : (j == cur_w);
                if (act) {
                    bf16x8 v0[4], v1[4];
                    if (j < cur_w) att_qk_sm<false, FIXED, true>(kcur + h2 * 8192, qr, m_s, l_s, nm, o0, o1, pw, 64 * j, 0, t, en, r32, hi, vcur + h2 * 8192, lane, v0, v1);
                    else att_qk_sm<true, FIXED>(kcur + h2 * 8192, qr, m_s, l_s, nm, o0, o1, pw, 64 * j, 0, t, en, r32, hi, vcur + h2 * 8192, lane, v0, v1);
                    pv_packed<FIXED>(vcur + h2 * 8192, lane, hi, v0, v1, pw, o0, o1, lacc, onesA);
                } }
        }
        if (FIXED) { const float l0 = __shfl(lacc[0], qi), l1 = __shfl(lacc[1], qi); l_s = hsel ? l1 : l0; } else l_s = half_swap_sum(l_s);
        const float sc = g1 / fmaxf(l_s, 1e-20f);
#pragma unroll
        for (int r = 0; r < 16; ++r) { IMP[r * 64 + lane] += o0[r] * sc; IMP[(16 + r) * 64 + lane] += o1[r] * sc; }
    }
    {
        const bf16_t* kb_ = (const bf16_t*)(ws + WS_KW) + (size_t)bg * SEQ * 64; const bf16_t* vb_ = (const bf16_t*)(ws + WS_VW) + (size_t)bg * SEQ * 64;
        const int j0 = (2 * qb - 8 > 0) ? 2 * qb - 8 : 0, jl = 2 * qb + 1;
        float m_w = -1e30f, l_w = 0.f; f32x16 o0 = F16Z, o1 = F16Z; nm = (f32x16)F16Z; f32x4 lacc = {0.f, 0.f, 0.f, 0.f};
        u32x4 pw[4];
        __syncthreads();
        for (int jp = j0; jp <= jl; jp += 2) {
            LAS unsigned char* kcur = KB + ((jp >> 1) & 1) * 16384; LAS unsigned char* vcur = VB + ((jp >> 1) & 1) * 16384;
            tile_st(kcur, vcur, wave, lane, kr, vr); tile_st(kcur + 8192, vcur + 8192, wave, lane, kr2, vr2);
            __syncthreads();
            if (jp + 2 <= jl) { tile_ld(kb_ + (size_t)(jp + 2) * 4096, vb_ + (size_t)(jp + 2) * 4096, wave, lane, kr, vr); tile_ld(kb_ + (size_t)(jp + 3) * 4096, vb_ + (size_t)(jp + 3) * 4096, wave, lane, kr2, vr2); }
#pragma unroll
            for (int h2 = 0; h2 < 2; ++h2) { const int j = jp + h2;
                const bool anyv = (64 * j <= t0 + 15) && (64 * j + 63 >= t0 - 511), allv = (64 * j + 63 <= t0) && (64 * j >= t0 + 15 - 511);
                if (anyv) {
                    bf16x8 v0[4], v1[4];
                    if (allv) att_qk_sm<false, FIXED>(kcur + h2 * 8192, qr, m_w, l_w, nm, o0, o1, pw, 64 * j, t - 511, t, true, r32, hi, vcur + h2 * 8192, lane, v0, v1);
                    else att_qk_sm<true, FIXED>(kcur + h2 * 8192, qr, m_w, l_w, nm, o0, o1, pw, 64 * j, t - 511, t, true, r32, hi, vcur + h2 * 8192, lane, v0, v1);
                    pv_packed<FIXED>(vcur + h2 * 8192, lane, hi, v0, v1, pw, o0, o1, lacc, onesA);
                } }
        }
        if (FIXED) { const float l0 = __shfl(lacc[0], qi), l1 = __shfl(lacc[1], qi); l_w = hsel ? l1 : l0; } else l_w = half_swap_sum(l_w);
        const float sc = g2 / fmaxf(l_w, 1e-20f);
#pragma unroll
        for (int r = 0; r < 16; ++r) { oa0[r] = IMP[r * 64 + lane] + o0[r] * sc; oa1[r] = IMP[(16 + r) * 64 + lane] + o1[r] * sc; }
    }
    bf16_t* mo = (bf16_t*)(ws + WS_MIX) + row * 1024 + 512 + hq * 64 + 4 * hi;
#pragma unroll
    for (int rq = 0; rq < 4; ++rq) { u32x2 w;
        w.x = cvt_pk_bf16(oa0[4 * rq], oa0[4 * rq + 1]); w.y = cvt_pk_bf16(oa0[4 * rq + 2], oa0[4 * rq + 3]); *(u32x2*)(mo + 8 * rq) = w;
        w.x = cvt_pk_bf16(oa1[4 * rq], oa1[4 * rq + 1]); w.y = cvt_pk_bf16(oa1[4 * rq + 2], oa1[4 * rq + 3]); *(u32x2*)(mo + 32 + 8 * rq) = w; }
}

__device__ __forceinline__ void wave_k_load(const bf16_t* kt, LAS unsigned char* kb, int lane) {
    LDS_WAIT();
    u32x4 kr[8];
#pragma unroll
    for (int c = 0; c < 8; ++c) kr[c] = *(const u32x4*)((const unsigned char*)kt + lane * 128 + c * 16);
#pragma unroll
    for (int c = 0; c < 8; ++c) *(LAS u32x4*)(kb + c * 1024 + lane * 16) = kr[c];
    LDS_WAIT();
}
__device__ __forceinline__ void wave_v_load(const bf16_t* vt, LAS unsigned char* vb, int lane) {
    LDS_WAIT();
    u32x4 vr[8];
#pragma unroll
    for (int c = 0; c < 8; ++c) vr[c] = *(const u32x4*)((const unsigned char*)vt + (16 * (c & 3) + (lane >> 2)) * 128 + (c >> 2) * 64 + (lane & 3) * 16);
#pragma unroll
    for (int c = 0; c < 8; ++c) *(LAS u32x4*)(vb + c * 1024 + lane * 16) = vr[c];
    LDS_WAIT();
}
struct F32Tile { f32x4 x[16]; };
__device__ __forceinline__ void f32_k_issue(F32Tile& T, const float* kp, int lane) {
    const float* kl = kp + (size_t)(lane >> 4) * 256 + (lane & 15) * 4;
#pragma unroll
    for (int i = 0; i < 16; ++i) T.x[i] = *(const f32x4*)(kl + (size_t)(4 * i) * 256);
}
template <int H> __device__ __forceinline__ void f32_k_commit(const F32Tile& T, LAS unsigned char* kb, int lane, float* kcopy, int skip) {
    const int pc = lane & 15, rl = lane >> 4, c = pc >> 1;
    float* kc = kcopy + (size_t)rl * 256 + pc * 4;
    const unsigned keo = (unsigned)(c * 1024 + (pc & 1) * 8 + ((rl + c) & 7) * 16);
    if (H == 0) LDS_WAIT();
#pragma unroll
    for (int i = 8 * H; i < 8 * H + 8; ++i) { u32x2 w; w.x = cvt_pk_bf16(T.x[i][0], T.x[i][1]); w.y = cvt_pk_bf16(T.x[i][2], T.x[i][3]);
        *(LAS u32x2*)(kb + ((i & 1) ? (keo ^ 64u) : keo) + 128 * (i >> 1)) = w;
        if (kcopy && 4 * i + rl >= skip) *(f32x4*)(kc + (size_t)(4 * i) * 256) = T.x[i]; }
    if (H == 1) LDS_WAIT();
}
struct F32Half { f32x4 x[8]; };
__device__ __forceinline__ void f32_v_issue(F32Half& T, const float* vp, int lane, int h) {
    const float* vl = vp + (size_t)(lane >> 4) * 256 + (lane & 15) * 4;
#pragma unroll
    for (int i = 0; i < 8; ++i) T.x[i] = *(const f32x4*)(vl + (size_t)(4 * (8 * h + i)) * 256);
}
__device__ __forceinline__ void f32_v_commit(const F32Half& T, LAS unsigned char* vb, int lane, float* vcopy, int skip, int h) {
    const int pc = lane & 15, rl = lane >> 4;
    LAS unsigned char* vd = vb + (pc >> 3) * 4096 + rl * 64 + (pc & 7) * 8; float* vc = vcopy + (size_t)rl * 256 + pc * 4;
#pragma unroll
    for (int i = 0; i < 8; ++i) { const int ri = 4 * (8 * h + i); u32x2 w; w.x = cvt_pk_bf16(T.x[i][0], T.x[i][1]); w.y = cvt_pk_bf16(T.x[i][2], T.x[i][3]);
        *(LAS u32x2*)(vd + ri * 64) = w;
        if (vcopy && ri + rl >= skip) *(f32x4*)(vc + (size_t)ri * 256) = T.x[i]; }
}
#define F32_TILE_STEP(kp_, vp_, kc_, vc_, skip_, key0_, klo_, khi_, en_, M_, L_, O0_, O1_) do { \
    F32Half TA_, TB_; \
    { F32Tile TK_; f32_k_issue(TK_, kp_, lane); f32_v_issue(TA_, vp_, lane, 0);     \
      f32_k_commit<0>(TK_, KB, lane, kc_, skip_); f32_v_issue(TB_, vp_, lane, 1); f32_k_commit<1>(TK_, KB, lane, kc_, skip_); } \
    qk_tile_sw(KB, qr, s0, s1, r32, hi); mask_tile(s0, s1, key0_, klo_, khi_, en_, hi); softmax_step(s0, s1, M_, L_, O0_, O1_); \
    LDS_WAIT(); f32_v_commit(TA_, VB, lane, vc_, skip_, 0); f32_v_commit(TB_, VB, lane, vc_, skip_, 1); LDS_WAIT(); pv_tile(VB, s0, s1, O0_, O1_, lane, hi); } while (0)

__device__ __forceinline__ void attn_decode_unit(const Params& P, const Ctx& C, int sg) {
    unsigned char* ws = P.ws; LAUNDER_GPTR(ws);
    const float* in6 = P.in[6]; const float* in7 = P.in[7]; float* outp = P.out;
    LAUNDER_GPTR(in6); LAUNDER_GPTR(in7); LAUNDER_GPTR(outp);
    int lane_ = fresh_lane();
    const int lane = lane_, wave = C.wave, r32 = lane & 31, hi = lane >> 5, r8 = r32 & 7;
    const int seq = sg >> 2, g = sg & 3, qi = r8 & 3, hsel = r8 >> 2, hq = 2 * g + hsel;
    const int t = PAST + qi;
    const size_t row = (size_t)NPR + seq * 4 + qi;
    bf16x8 qr[4];
    { const bf16_t* qp = (const bf16_t*)(ws + WS_Q) + row * 512 + hq * 64 + hi * 8;
#pragma unroll
      for (int d0 = 0; d0 < 4; ++d0) qr[d0] = *(const bf16x8*)(qp + d0 * 16); }
    LAS unsigned char* KB = C.lds + wave * 16384; LAS unsigned char* VB = KB + 8192;
    LAS float* ML = (LAS float*)(C.lds + DC_ML); LAS float* DIMP = (LAS float*)(C.lds + DC_IMP); LAS unsigned* DSEL = (LAS unsigned*)(C.lds + DC_SEL);
    LAS float* DOC = (LAS float*)(C.lds + DC_OC);
    f32x16 s0, s1;
    float m_w = -1e30f, l_w = 0.f; f32x16 ow0 = F16Z, ow1 = F16Z;
    __syncthreads();
    if (wave == 0) {
        const bf16_t* kcb = (const bf16_t*)(ws + WS_KCC) + ((size_t)4096 + sg * 128) * 64; const bf16_t* vcb = (const bf16_t*)(ws + WS_VCC) + ((size_t)4096 + sg * 128) * 64;
        const int cmax = (t - 31) >> 4;
        f32x16 oc0 = F16Z, oc1 = F16Z; float carry = 0.f; float val0[8], val1[8];
        u32x4 k0r[8], v0r[8], k1r[8], v1r[8];
        wave_tile_issue(kcb, vcb, lane, k0r, v0r); wave_tile_issue(kcb + 4096, vcb + 4096, lane, k1r, v1r);
        wave_tile_commit(k0r, v0r, KB, VB, lane); qk_tile(KB, qr, s0, s1, r32, hi); mask_tile(s0, s1, 0, 0, cmax, true, hi);
        const float m0 = tile_max(s0, s1); float l0 = 0.f;
#pragma unroll
        for (int r = 0; r < 16; ++r) { s0[r] = fast_exp2(s0[r] - m0); s1[r] = fast_exp2(s1[r] - m0); l0 += s0[r] + s1[r]; }
        imp_tile(s0, s1, hi, carry, val0);
        pv_tile(VB, s0, s1, oc0, oc1, lane, hi);
        wave_tile_commit(k1r, v1r, KB, VB, lane); qk_tile(KB, qr, s0, s1, r32, hi); mask_tile(s0, s1, 64, 0, cmax, true, hi);
        const float m1 = fmaxf(m0, tile_max(s0, s1)); const float a = fast_exp2(m0 - m1); float l1 = 0.f;
#pragma unroll
        for (int r = 0; r < 16; ++r) { s0[r] = fast_exp2(s0[r] - m1); s1[r] = fast_exp2(s1[r] - m1); l1 += s0[r] + s1[r]; }
        carry *= a; oc0 = oc0 * a; oc1 = oc1 * a;
        imp_tile(s0, s1, hi, carry, val1);
        pv_tile(VB, s0, s1, oc0, oc1, lane, hi);
        const float inv = 1.0f / fmaxf(half_swap_sum(l0 * a + l1), 1e-20f); const float inva = inv * a;
#pragma unroll
        for (int gi = 0; gi < 8; ++gi) { float w0 = val0[gi] * inva, w1 = val1[gi] * inv;
            w0 += __shfl_xor(w0, 4); w1 += __shfl_xor(w1, 4);
            if (r32 < 4) { DIMP[r32 * 64 + 2 * gi + hi] = w0; DIMP[r32 * 64 + 16 + 2 * gi + hi] = w1; } }
        if (lane < 4) DIMP[lane * 64 + 32] = 0.f;
#pragma unroll
        for (int r = 0; r < 16; ++r) { DOC[r * 64 + lane] = oc0[r] * inv; DOC[(16 + r) * 64 + lane] = oc1[r] * inv; }
        LDS_WAIT();
        { const int tq = (lane >> 2) & 3, sub = lane & 3, cur = (PAST + tq) >> 6;
          const unsigned m = topk_select(DIMP + tq * 64, cur, sub);
          if (lane < 16 && sub < 2) DSEL[tq * 2 + sub] = m; }
        LDS_WAIT();
    }
    const float* sk = in6 + (size_t)seq * (512 * 256) + g * 64; const float* sv = in7 + (size_t)seq * (512 * 256) + g * 64;
    float* ck = outp + O_SKW + (size_t)seq * (512 * 256) + g * 64; float* cv = outp + O_SVW + (size_t)seq * (512 * 256) + g * 64;
    if (wave != 0) { const int j = wave;
        F32_TILE_STEP(sk + (size_t)j * 64 * 256, sv + (size_t)j * 64 * 256, ck + ((ptrdiff_t)j * 64 - 4) * 256, cv + ((ptrdiff_t)j * 64 - 4) * 256, 0, 64 * j, qi + 1, 512 + qi, true, m_w, l_w, ow0, ow1); }
    __syncthreads();
    float m_s = -1e30f, l_s = 0.f; f32x16 os0 = F16Z, os1 = F16Z;
    if (wave == 0) {
        F32_TILE_STEP(sk, sv, ck - 4 * 256, cv - 4 * 256, 4, 0, qi + 1, 512 + qi, true, m_w, l_w, ow0, ow1);
        wave_tile_load((const bf16_t*)(ws + WS_CWK) + (size_t)sg * 4096, (const bf16_t*)(ws + WS_CWV) + (size_t)sg * 4096, KB, VB, lane);
        qk_tile(KB, qr, s0, s1, r32, hi); mask_tile(s0, s1, 512, qi + 1, 512 + qi, true, hi);
        softmax_step(s0, s1, m_w, l_w, ow0, ow1); pv_tile(VB, s0, s1, ow0, ow1, lane, hi);
    }
    if (wave != 0) {
      unsigned selw[4]; selw[0] = DSEL[qi * 2]; selw[1] = DSEL[qi * 2 + 1]; selw[2] = 0u; selw[3] = 0u;
      const int* in8 = (const int*)P.in[8]; LAUNDER_GPTR(in8); const int* pt = in8 + seq * 16;
      for (int j = wave - 1; j <= 32; j += 7) {
          const bool en = ((sel_word(selw, j) >> (j & 31)) & 1u) && (64 * j <= t);
          if (__any(en)) {
              if (j < 32) { const size_t po = (size_t)pt[j >> 1] * (128 * 256) + (size_t)(j & 1) * 64 * 256 + g * 64;
                  const float* in4 = P.in[4]; const float* in5 = P.in[5]; LAUNDER_GPTR(in4); LAUNDER_GPTR(in5);
                  F32_TILE_STEP(in4 + po, in5 + po, (float*)nullptr, (float*)nullptr, 0, 64 * j, 0, t, en, m_s, l_s, os0, os1); }
              else { wave_tile_load((const bf16_t*)(ws + WS_CKS) + (size_t)sg * 4096, (const bf16_t*)(ws + WS_CVS) + (size_t)sg * 4096, KB, VB, lane);
                  qk_tile(KB, qr, s0, s1, r32, hi); mask_tile(s0, s1, 64 * j, 0, t, en, hi);
                  softmax_step(s0, s1, m_s, l_s, os0, os1); pv_tile(VB, s0, s1, os0, os1, lane, hi); } } } }
    LDS_WAIT();
    { LAS float* ml = ML + wave * 256 + lane * 4; ml[0] = m_s; ml[1] = l_s; ml[2] = m_w; ml[3] = l_w;
      LAS float* ob = (LAS float*)KB;
#pragma unroll
      for (int r = 0; r < 16; ++r) { ob[r * 64 + lane] = os0[r]; ob[(16 + r) * 64 + lane] = os1[r]; ob[(32 + r) * 64 + lane] = ow0[r]; ob[(48 + r) * 64 + lane] = ow1[r]; } }
    __syncthreads();
    {
        float Ms = -1e30f, Mw = -1e30f;
#pragma unroll
        for (int w = 0; w < 8; ++w) { Ms = fmaxf(Ms, ML[w * 256 + lane * 4]); Mw = fmaxf(Mw, ML[w * 256 + lane * 4 + 2]); }
        float Ls = 0.f, Lw = 0.f, fs[8], fw[8];
#pragma unroll
        for (int w = 0; w < 8; ++w) { const LAS float* ml = ML + w * 256 + lane * 4; fs[w] = fast_exp2(ml[0] - Ms); fw[w] = fast_exp2(ml[2] - Mw); Ls += ml[1] * fs[w]; Lw += ml[3] * fw[w]; }
        const float* gts = (const float*)(ws + WS_GATES) + row * 24 + hq * 3;
        const float g0 = gts[0], scs = gts[1] / fmaxf(half_swap_sum(Ls), 1e-20f), scw = gts[2] / fmaxf(half_swap_sum(Lw), 1e-20f);
        float a0[2], a1[2];
#pragma unroll
        for (int k = 0; k < 2; ++k) { const int r = 2 * wave + k; a0[k] = DOC[r * 64 + lane] * g0; a1[k] = DOC[(16 + r) * 64 + lane] * g0; }
#pragma unroll
        for (int w = 0; w < 8; ++w) { const LAS float* ob = (const LAS float*)(C.lds + w * 16384); const float f1 = fs[w] * scs, f2 = fw[w] * scw;
#pragma unroll
            for (int k = 0; k < 2; ++k) { const int r = 2 * wave + k;
                a0[k] += ob[r * 64 + lane] * f1 + ob[(32 + r) * 64 + lane] * f2; a1[k] += ob[(16 + r) * 64 + lane] * f1 + ob[(48 + r) * 64 + lane] * f2; } }
        if (r32 < 8) {
            bf16_t* mo = (bf16_t*)(ws + WS_MIX) + row * 1024 + 512 + hq * 64 + 4 * hi + 8 * (wave >> 1) + 2 * (wave & 1);
            *(unsigned*)mo = cvt_pk_bf16(a0[0], a0[1]);
            *(unsigned*)(mo + 32) = cvt_pk_bf16(a1[0], a1[1]); }
    }
}

constexpr int CW_QUEUE = 16384;
__device__ __forceinline__ void phase_attention(const Params& P, const Ctx& C, int parts, int qset) {
    unsigned* qc = (unsigned*)(P.ws + WS_CTL) + CW_QUEUE + qset * 512;
    volatile LAS unsigned* slot = (volatile LAS unsigned*)(C.lds + MISC_OFF) + 16;
    const bool fixed_ok = ((const float*)(P.ws + WS_PEB))[768] < 100.f;
    const int x0 = (int)(xb_xcc_id() & 7u);
    for (int i = 0; i < 8; ++i) { const int x = (x0 + i) & 7;
        for (;;) {
            __syncthreads();
            if (C.wave == 0 && fresh_lane() == 0) *slot = __hip_atomic_fetch_add(qc + 64 * x, 1u, __ATOMIC_RELAXED, __HIP_MEMORY_SCOPE_AGENT);
            __syncthreads();
            const unsigned u = *slot;
            if (u >= 128u) break;
            const int us = __builtin_amdgcn_readfirstlane((int)u);
            int pq = -1, dq = -1;
            if (us < 96) { const int k = us / 3, r = us - 3 * k; if (r == 0) pq = 63 - k; else dq = 2 * k + r - 1; } else pq = 127 - us;
            if (pq >= 0) { if (parts & 1) { if (fixed_ok) attn_prompt_unit<true>(P, C, x, pq); else attn_prompt_unit<false>(P, C, x, pq); } }
            else { if (parts & 2) attn_decode_unit(P, C, x * 64 + dq); }
        }
    }
}
constexpr int N_PHASES = 10;

__global__ void __launch_bounds__(NWAVES * 64, 2) fwd_kernel(Params P) {
    extern __shared__ __attribute__((aligned(16))) unsigned char lds_raw[];
    Ctx C;
    C.lds = (LAS unsigned char*)lds_raw;
    C.wave = __builtin_amdgcn_readfirstlane(threadIdx.x >> 6);
    C.nblk = gridDim.x; C.blk = blockIdx.x;
    volatile LAS unsigned* MISC = (volatile LAS unsigned*)(C.lds + MISC_OFF);
    for (int u = threadIdx.x; u < (LDS_BYTES - LDSCTL_OFF) / 4; u += NWAVES * 64) ((LAS unsigned*)(C.lds + LDSCTL_OFF))[u] = 0u;
    __syncthreads();
    unsigned* ctl = (unsigned*)(P.ws + WS_CTL);
    XcdBarrier bar = xcd_barrier_post(ctl + CW_BAR + P.li * XCD_BAR_WORDS, MISC + 8);
    const int lo = P.ph_lo, hi = P.ph_hi;
#ifndef PHASE_MASK
#define PHASE_MASK 0x3ff
#endif
#define IN(k) (((PHASE_MASK >> (k)) & 1) && lo <= (k) && (k) < hi)
#define SEAM(k) do { if (IN(k) && IN((k) + 1)) xcd_barrier(bar, C.wave); } while (0)
    const int vblk = (C.nblk % 8 == 0) ? (C.blk % 8) * (C.nblk / 8) + C.blk / 8 : C.blk; (void)vblk;

#define PH0 { phase_prologue(P, C, P.pad & 31); }
#define PH1 { phase_modulate<0>(P, C); }
#define PH2 { const int cgrp = (C.blk >> 3) & 1;     \
        _Pragma("unroll 1") for (int s_ = 0; s_ < 2; ++s_) { \
        if ((s_ == 0) == (cgrp == 0)) cache_convert(P, C); \
        if (s_ == 0) { pg8::Gemm g{(const bf16_t*)(ws + WS_H), (const bf16_t*)(ws + WS_WTIN), NR, INCP, DM, DM, DM}; pg8::StaticOrder S; S.init(NR, INCP, C.nblk, C.blk); \
          pg8::EpiProj E{&P}; pg8::gemm_phase<pg8::EpiProj, pg8::StaticOrder, true, true>(C.lds, g, S, E, C.wave); } } }
#define PH3 { { pg8::Gemm g{nullptr, nullptr, NCROWS, 256, 2048, 1024, 2048}; \
          pg8::CmpOrder<0> S{(const char*)(ws + WS_AK), (const char*)(ws + WS_AV), (const char*)(ws + WS_WTC1K), (const char*)(ws + WS_WTC1V), C.nblk, C.blk}; \
          pg8::EpiCmp E{(bf16_t*)(ws + WS_HIDK), (bf16_t*)(ws + WS_HIDV), (const float*)(ws + WS_PEB)}; pg8::gemm_phase<pg8::EpiCmp, pg8::CmpOrder<0>, true, true>(C.lds, g, S, E, C.wave); VM_WAIT(); __syncthreads(); \
          { pg8::Unit u_; for (int i_ = 0; S.next(i_, u_); ++i_) cmp2_tile(P, C, u_.kind, u_.pm); } }     \
        const bool split = C.nblk >= 64; \
        if (!split || C.blk < 32) { pg8::Gemm g{nullptr, nullptr, NCROWS, 256, 2048, 1024, 2048}; \
          pg8::CmpOrder<1> S{(const char*)(ws + WS_AK), (const char*)(ws + WS_AV), (const char*)(ws + WS_WTC1K), (const char*)(ws + WS_WTC1V), C.nblk, C.blk}; \
          pg8::EpiCmp E{(bf16_t*)(ws + WS_HIDK), (bf16_t*)(ws + WS_HIDV), (const float*)(ws + WS_PEB)}; pg8::gemm_phase<pg8::EpiCmp, pg8::CmpOrder<1>, true, true>(C.lds, g, S, E, C.wave); VM_WAIT(); __syncthreads(); \
          { pg8::Unit u_; for (int i_ = 0; S.next(i_, u_); ++i_) cmp2_tile(P, C, u_.kind, u_.pm); } } \
        if (!split) phase_chunk_mlp(P, C, C.blk, C.nblk); else if (C.blk >= 32) phase_chunk_mlp(P, C, C.blk - 32, C.nblk - 32); }
#define PH4 { }
#define PH5 { phase_attention(P, C, (P.pad >> 8) & 3, P.li); }
#define PH6 { pg8::Gemm g{(const bf16_t*)(ws + WS_MIX), (const bf16_t*)(ws + WS_WTOUT), NPR, DM, DM, DM, DM}; pg8::StaticOrder S; S.init(NPR, DM, C.nblk, C.blk); \
        pg8::EpiResid<0> E{&P}; pg8::gemm_phase<pg8::EpiResid<0>, pg8::StaticOrder, true, true>(C.lds, g, S, E, C.wave); sample_rows_gemm<0>(P, C); }
#define PH7 { phase_modulate<1>(P, C); }
#define PH8 { pg8::Gemm g{(const bf16_t*)(ws + WS_H), (const bf16_t*)(ws + WS_WTF1), NR, 2 * DFF, DM, DM, DM}; pg8::StaticOrder S; S.init(NR, 2 * DFF, C.nblk, C.blk); \
        pg8::EpiSwiglu E{&P}; pg8::gemm_phase<pg8::EpiSwiglu, pg8::StaticOrder, true, true>(C.lds, g, S, E, C.wave); }
#define PH9 { pg8::Gemm g{(const bf16_t*)(ws + WS_F), (const bf16_t*)(ws + WS_WTF2), NPR, DM, DFF, DFF, DFF}; pg8::StaticOrder S; S.init(NPR, DM, C.nblk, C.blk); \
        pg8::EpiResid<1> E{&P}; pg8::gemm_phase<pg8::EpiResid<1>, pg8::StaticOrder, true, true>(C.lds, g, S, E, C.wave); sample_rows_gemm<1>(P, C); }
#define RUN(k, BODY) do { if (IN(k)) { unsigned char* ws = P.ws; LAUNDER_GPTR(ws); BODY } } while (0)
    RUN(0, PH0); SEAM(0);
    RUN(1, PH1); SEAM(1);
    RUN(2, PH2); SEAM(2);
    RUN(3, PH3); SEAM(3);
    RUN(4, PH4);
    RUN(5, PH5); SEAM(5);
    RUN(6, PH6); SEAM(6);
    RUN(7, PH7); SEAM(7);
    RUN(8, PH8); SEAM(8);
    RUN(9, PH9);
#undef IN
#undef SEAM
}

extern "C" void kernel_launch(void* const* d_in, const int* in_sizes, int n_in, void* d_out, int out_size, void* d_ws, size_t ws_size, hipStream_t stream) {
    static int grid = 0;
    if (grid == 0) {
        if (n_in != 32 || out_size != (int)O_TOTAL || ws_size < WS_END) { fprintf(stderr, "kernel_launch: unexpected shapes (n_in %d, out %d, ws %zu)\n", n_in, out_size, ws_size); grid = -1; return; }
        int dev = 0, cus = 0, per_cu = 0;
        if (hipGetDevice(&dev) != hipSuccess || hipDeviceGetAttribute(&cus, hipDeviceAttributeMultiprocessorCount, dev) != hipSuccess) { grid = -1; return; }
        if (hipFuncSetAttribute((const void*)fwd_kernel, hipFuncAttributeMaxDynamicSharedMemorySize, LDS_BYTES) != hipSuccess) { fprintf(stderr, "kernel_launch: hipFuncSetAttribute failed\n"); grid = -1; return; }
        if (hipOccupancyMaxActiveBlocksPerMultiprocessor(&per_cu, (const void*)fwd_kernel, NWAVES * 64, LDS_BYTES) != hipSuccess || per_cu < 1) { fprintf(stderr, "kernel_launch: occupancy query says %d\n", per_cu); per_cu = 1; }
        (void)hipGetLastError();
        grid = cus;
    }
    if (grid < 0) return;
    (void)hipMemsetAsync((char*)d_ws + WS_CTL, 0, CTL_ZERO_BYTES, stream);
    Params p{};
    for (int i = 0; i < 32; ++i) p.in[i] = (const float*)d_in[i];
    p.out = (float*)d_out; p.ws = (unsigned char*)d_ws;
#ifndef PROBE_PHASE
#define PROBE_PHASE -1
#endif
#ifndef PROBE_ATT
#define PROBE_ATT 31
#endif
    const int nl = (PROBE_PHASE >= 0) ? 2 : 1;
    for (int li = 0; li < nl; ++li) {
        p.ph_lo = (li == 0) ? 0 : PROBE_PHASE; p.ph_hi = (nl == 2 && li == 0) ? PROBE_PHASE + 1 : N_PHASES; p.li = li; p.pad = (nl == 2 && li == 1) ? ((PROBE_PHASE == 0 ? PROBE_ATT : 31) | ((PROBE_PHASE == 5 ? PROBE_ATT : 3) << 8)) : (31 | (3 << 8));
        hipLaunchKernelGGL(fwd_kernel, dim3(grid), dim3(NWAVES * 64), LDS_BYTES, stream, p);
    }
}
```
